# Optimizing an MI355X kernel written in HIP

```python
import math
import numpy as np
import jax
import jax.numpy as jnp
from jax import lax

D_MODEL = 2048
BATCH = 4
SEQ = 4096
DEPTH = 2

HEAD_DIM = 128
Q_BLOCK = 128
ROPE_THETA = 10000.0
EPS = 1e-6

NSA_HEADS = D_MODEL // (2 * HEAD_DIM)
NSA_KV_HEADS = NSA_HEADS // 4
NSA_CMP_LEN = 32
NSA_CMP_STRIDE = 16
NSA_CMP_HIDDEN = 2 * HEAD_DIM
NSA_SLC_LEN = 64
NSA_SLC_TOPK = 8
NSA_WINDOW = 512
DIFF_VDIM = 2 * HEAD_DIM
DIFF_HEADS = D_MODEL // (2 * DIFF_VDIM)
NSA_WIDTH = NSA_HEADS * HEAD_DIM
DIFF_WIDTH = DIFF_HEADS * DIFF_VDIM
MIX_WIDTH = NSA_WIDTH + DIFF_WIDTH
EVEN_SPLITS = (NSA_WIDTH, 6 * NSA_KV_HEADS * HEAD_DIM, 3 * NSA_HEADS,
               2 * DIFF_HEADS * HEAD_DIM, 2 * DIFF_HEADS * HEAD_DIM, DIFF_WIDTH)
EVEN_IN = sum(EVEN_SPLITS)

FOX_HEADS = D_MODEL // HEAD_DIM
FOX_WIDTH = FOX_HEADS * HEAD_DIM
ODD_IN = 3 * FOX_WIDTH + FOX_HEADS

MEM_LEN = 256
MEM_HEADS = 4
MEM_WIDTH = MEM_HEADS * HEAD_DIM

N_GROUPS = 4
EXPERTS_PER_GROUP = 8
N_EXPERTS = N_GROUPS * EXPERTS_PER_GROUP
EXPERT_TOPK = 2
EXPERT_FF = D_MODEL // 4
MOE_BLOCK = 128

kernel_name = 'hybrid_nsa_diff_fox_hmoe'


def _split_points(sizes):
    return [int(v) for v in np.cumsum(sizes)[:-1]]


def rmsnorm(x, g):
    xf = x.astype(jnp.float32)
    y = xf * lax.rsqrt(jnp.mean(xf * xf, axis=-1, keepdims=True) + EPS)
    return (y * g.astype(jnp.float32)).astype(x.dtype)


def rope(x, pos):
    half = HEAD_DIM // 2
    inv = ROPE_THETA ** (-jnp.arange(half, dtype=jnp.float32) / half)
    ang = jnp.asarray(pos).astype(jnp.float32)[:, None] * inv[None, :]
    cos, sin = jnp.cos(ang), jnp.sin(ang)
    xf = x.astype(jnp.float32)
    x1, x2 = xf[..., :half], xf[..., half:]
    return jnp.concatenate([x1 * cos - x2 * sin, x2 * cos + x1 * sin], axis=-1).astype(x.dtype)


def masked_softmax(s, mask):
    s = jnp.where(mask, s, -jnp.inf)
    m = jnp.max(s, axis=-1, keepdims=True)
    m = jnp.where(jnp.isfinite(m), m, 0.0)
    e = jnp.where(mask, jnp.exp(s - m), 0.0)
    return e / jnp.maximum(jnp.sum(e, axis=-1, keepdims=True), 1e-30)


def nsa_attention(q, k_cmp, v_cmp, k_slc, v_slc, k_win, v_win, gates, g_kc, cmp_pe, cmp_w1, cmp_w2):
    B, G, R, T, dh = q.shape
    dt = q.dtype
    scale = dh ** -0.5
    L, S, Ls, W = NSA_CMP_LEN, NSA_CMP_STRIDE, NSA_SLC_LEN, NSA_WINDOW
    n_cmp = (T - L) // S + 1
    n_slc = T // Ls
    topk = min(NSA_SLC_TOPK, n_slc)
    cmp_idx = np.arange(n_cmp)[:, None] * S + np.arange(L)[None, :]
    cmp_end = cmp_idx[:, -1]
    starts = np.arange(n_cmp) * S
    sb = np.arange(n_slc) * Ls
    overlap = np.clip(np.minimum(starts[:, None] + L, sb[None, :] + Ls)
                      - np.maximum(starts[:, None], sb[None, :]), 0, None) / L
    overlap = jnp.asarray(overlap, jnp.float32)
    cmp_end_j = jnp.asarray(cmp_end)

    def compress(t, i):
        blocks = t[:, :, cmp_idx] + cmp_pe[i]
        hid = jax.nn.gelu(blocks.reshape(B, G, n_cmp, L * dh) @ cmp_w1[i])
        return hid @ cmp_w2[i]

    kc = rope(rmsnorm(compress(k_cmp, 0), g_kc), cmp_end)
    vc = compress(v_cmp, 1)
    ks_blk = k_slc.reshape(B, G, n_slc, Ls, dh)
    vs_blk = v_slc.reshape(B, G, n_slc, Ls, dh)
    kw_pad = jnp.pad(k_win, ((0, 0), (0, 0), (W, 0), (0, 0)))
    vw_pad = jnp.pad(v_win, ((0, 0), (0, 0), (W, 0), (0, 0)))
    bi = jnp.arange(B)[:, None, None, None]
    gi = jnp.arange(G)[None, :, None, None]
    jblk = jnp.arange(n_slc)[None, :]

    def block(b):
        q0 = b * Q_BLOCK
        qpos = q0 + jnp.arange(Q_BLOCK)
        qb = lax.dynamic_slice_in_dim(q, q0, Q_BLOCK, axis=3)
        gb = lax.dynamic_slice_in_dim(gates, q0, Q_BLOCK, axis=3)
        s_c = jnp.einsum('bgrqd,bgnd->bgrqn', qb, kc).astype(jnp.float32) * scale
        p_c = masked_softmax(s_c, cmp_end_j[None, :] <= qpos[:, None])
        o_c = jnp.einsum('bgrqn,bgnd->bgrqd', p_c.astype(dt), vc)
        imp = jnp.einsum('bgrqn,nj->bgqj', p_c, overlap)
        qblk = (qpos // Ls)[:, None]
        forced = (jblk == 0) | (jblk == qblk) | (jblk == qblk - 1)
        imp = jnp.where(jblk > qblk, -jnp.inf, jnp.where(forced, jnp.inf, imp))
        _, sel = lax.top_k(imp, topk)
        k_sel = ks_blk[bi, gi, sel]
        v_sel = vs_blk[bi, gi, sel]
        kpos = sel[..., None] * Ls + jnp.arange(Ls)
        mask_s = (kpos <= qpos[:, None, None]).reshape(B, G, 1, Q_BLOCK, topk * Ls)
        s_s = jnp.einsum('bgrqd,bgqnld->bgrqnl', qb, k_sel).astype(jnp.float32) * scale
        p_s = masked_softmax(s_s.reshape(B, G, R, Q_BLOCK, topk * Ls), mask_s)
        p_s = p_s.reshape(B, G, R, Q_BLOCK, topk, Ls)
        o_s = jnp.einsum('bgrqnl,bgqnld->bgrqd', p_s.astype(dt), v_sel)
        kw = lax.dynamic_slice_in_dim(kw_pad, q0, Q_BLOCK + W, axis=2)
        vw = lax.dynamic_slice_in_dim(vw_pad, q0, Q_BLOCK + W, axis=2)
        wpos = q0 - W + jnp.arange(Q_BLOCK + W)
        rel = qpos[:, None] - wpos[None, :]
        mask_w = (rel >= 0) & (rel < W) & (wpos[None, :] >= 0)
        s_w = jnp.einsum('bgrqd,bgkd->bgrqk', qb, kw).astype(jnp.float32) * scale
        o_w = jnp.einsum('bgrqk,bgkd->bgrqd', masked_softmax(s_w, mask_w).astype(dt), vw)
        return gb[..., 0:1] * o_c + gb[..., 1:2] * o_s + gb[..., 2:3] * o_w

    out = lax.map(block, jnp.arange(T // Q_BLOCK))
    return out.transpose(1, 2, 3, 0, 4, 5).reshape(B, G * R, T, dh)


def diff_attention(q, k, v, lam_p, sub_g, layer):
    B, H, _, T, dh = q.shape
    dt = v.dtype
    scale = dh ** -0.5
    lam_init = 0.8 - 0.6 * math.exp(-0.3 * layer)
    lp = lam_p.astype(jnp.float32)
    lam = jnp.exp(jnp.sum(lp[0] * lp[1])) - jnp.exp(jnp.sum(lp[2] * lp[3])) + lam_init
    outs = []
    for b in range(T // Q_BLOCK):
        lo, hi = b * Q_BLOCK, (b + 1) * Q_BLOCK
        mask = jnp.arange(hi)[None, :] <= jnp.arange(lo, hi)[:, None]
        s = jnp.einsum('bhmqd,bhmkd->bhmqk', q[:, :, :, lo:hi], k[:, :, :, :hi]).astype(jnp.float32) * scale
        p = masked_softmax(s, mask)
        a = p[:, :, 0] - lam * p[:, :, 1]
        outs.append(jnp.einsum('bhqk,bhkd->bhqd', a.astype(dt), v[:, :, :hi]))
    o = jnp.concatenate(outs, axis=2)
    return rmsnorm(o, sub_g) * (1.0 - lam_init)


def forgetting_attention(q, k, v, c):
    B, H, T, dh = q.shape
    dt = v.dtype
    scale = dh ** -0.5
    outs = []
    for b in range(T // Q_BLOCK):
        lo, hi = b * Q_BLOCK, (b + 1) * Q_BLOCK
        mask = jnp.arange(hi)[None, :] <= jnp.arange(lo, hi)[:, None]
        s = (jnp.einsum('bhqd,bhkd->bhqk', q[:, :, lo:hi], k[:, :, :hi]).astype(jnp.float32) * scale
             + c[:, :, lo:hi, None] - c[:, :, None, :hi])
        p = masked_softmax(s, mask)
        outs.append(jnp.einsum('bhqk,bhkd->bhqd', p.astype(dt), v[:, :, :hi]))
    return jnp.concatenate(outs, axis=2)


def even_mixer(h, w_in, w_out, nsa_qk_g, cmp_pe, cmp_w1, cmp_w2, diff_qk_g, diff_lam, diff_sub_g, layer):
    B, T, _ = h.shape
    G, R = NSA_KV_HEADS, NSA_HEADS // NSA_KV_HEADS
    pos = jnp.arange(T)
    zq, zkv, zg, zdq, zdk, zdv = jnp.split(h @ w_in, _split_points(EVEN_SPLITS), axis=-1)
    q = rope(rmsnorm(zq.reshape(B, T, NSA_HEADS, HEAD_DIM), nsa_qk_g[0]).transpose(0, 2, 1, 3), pos)
    q = q.reshape(B, G, R, T, HEAD_DIM)
    kv = zkv.reshape(B, T, 3, 2, G, HEAD_DIM).transpose(2, 3, 0, 4, 1, 5)
    k_slc = rope(rmsnorm(kv[1, 0], nsa_qk_g[2]), pos)
    k_win = rope(rmsnorm(kv[2, 0], nsa_qk_g[3]), pos)
    gates = jax.nn.sigmoid(zg.reshape(B, T, G, R, 3)).transpose(0, 2, 3, 1, 4)
    o_nsa = nsa_attention(q, kv[0, 0], kv[0, 1], k_slc, kv[1, 1], k_win, kv[2, 1], gates,
                          nsa_qk_g[1], cmp_pe, cmp_w1, cmp_w2)
    o_nsa = o_nsa.transpose(0, 2, 1, 3).reshape(B, T, NSA_WIDTH)
    dq = rope(rmsnorm(zdq.reshape(B, T, DIFF_HEADS, 2, HEAD_DIM), diff_qk_g[0]).transpose(0, 2, 3, 1, 4), pos)
    dk = rope(rmsnorm(zdk.reshape(B, T, DIFF_HEADS, 2, HEAD_DIM), diff_qk_g[1]).transpose(0, 2, 3, 1, 4), pos)
    dv = zdv.reshape(B, T, DIFF_HEADS, DIFF_VDIM).transpose(0, 2, 1, 3)
    o_diff = diff_attention(dq, dk, dv, diff_lam, diff_sub_g, layer)
    o_diff = o_diff.transpose(0, 2, 1, 3).reshape(B, T, DIFF_WIDTH)
    return jnp.concatenate([o_nsa, o_diff], axis=-1) @ w_out


def odd_mixer(h, w_in, w_out, f_b, qk_g):
    B, T, _ = h.shape
    zq, zk, zv, zf = jnp.split(h @ w_in, [FOX_WIDTH, 2 * FOX_WIDTH, 3 * FOX_WIDTH], axis=-1)
    q = rmsnorm(zq.reshape(B, T, FOX_HEADS, HEAD_DIM), qk_g[0]).transpose(0, 2, 1, 3)
    k = rmsnorm(zk.reshape(B, T, FOX_HEADS, HEAD_DIM), qk_g[1]).transpose(0, 2, 1, 3)
    v = zv.reshape(B, T, FOX_HEADS, HEAD_DIM).transpose(0, 2, 1, 3)
    log_f = jax.nn.log_sigmoid(zf.astype(jnp.float32) + f_b.astype(jnp.float32)).transpose(0, 2, 1)
    c = jnp.cumsum(log_f, axis=-1)
    o = forgetting_attention(q, k, v, c)
    return o.transpose(0, 2, 1, 3).reshape(B, T, FOX_WIDTH) @ w_out


def memory_cross_attention(h, m, wq, wkv, qk_g, wo):
    B, T, _ = h.shape
    M = m.shape[1]
    q = rmsnorm((h @ wq).reshape(B, T, MEM_HEADS, HEAD_DIM), qk_g[0])
    kv = (m @ wkv).reshape(B, M, 2, MEM_HEADS, HEAD_DIM)
    k = rmsnorm(kv[:, :, 0], qk_g[1])
    s = jnp.einsum('bthd,bmhd->bhtm', q, k).astype(jnp.float32) * (HEAD_DIM ** -0.5)
    p = jax.nn.softmax(s, axis=-1)
    o = jnp.einsum('bhtm,bmhd->bthd', p.astype(h.dtype), kv[:, :, 1]).reshape(B, T, MEM_WIDTH)
    return o @ wo


def hier_moe(h, wg, bg, we, be, w1, w3, w2):
    B, T, D = h.shape
    N = B * T
    dt = h.dtype
    hf = h.reshape(N, D)
    p_grp = jax.nn.softmax((hf @ wg).astype(jnp.float32) + bg.astype(jnp.float32), axis=-1)
    grp = jnp.argmax(p_grp, axis=-1)
    p_top_grp = jnp.max(p_grp, axis=-1)
    le = ((hf @ we).astype(jnp.float32) + be.astype(jnp.float32)).reshape(N, N_GROUPS, EXPERTS_PER_GROUP)
    le = jnp.take_along_axis(le, grp[:, None, None], axis=1)[:, 0]
    p_in, j_in = lax.top_k(jax.nn.softmax(le, axis=-1), EXPERT_TOPK)
    wts = p_top_grp[:, None] * p_in / jnp.sum(p_in, axis=-1, keepdims=True)
    eid = (grp[:, None] * EXPERTS_PER_GROUP + j_in).reshape(-1).astype(jnp.int32)
    tok = jnp.repeat(jnp.arange(N, dtype=jnp.int32), EXPERT_TOPK)
    wflat = wts.reshape(-1)
    M = N * EXPERT_TOPK
    order = jnp.argsort(eid)
    e_s, tok_s, w_s = eid[order], tok[order], wflat[order]
    counts = jnp.zeros((N_EXPERTS,), jnp.int32).at[eid].add(1)
    start = jnp.cumsum(counts) - counts
    pcounts = (counts + MOE_BLOCK - 1) // MOE_BLOCK * MOE_BLOCK
    pend = jnp.cumsum(pcounts)
    pstart = pend - pcounts
    dest = pstart[e_s] + jnp.arange(M, dtype=jnp.int32) - start[e_s]
    n_blk = -(-M // MOE_BLOCK) + N_EXPERTS
    P = n_blk * MOE_BLOCK
    buf_tok = jnp.full((P,), N, jnp.int32).at[dest].set(tok_s)
    buf_w = jnp.zeros((P,), jnp.float32).at[dest].set(w_s)
    blk_e = jnp.minimum(jnp.searchsorted(pend, jnp.arange(n_blk, dtype=jnp.int32) * MOE_BLOCK, side='right'),
                        N_EXPERTS - 1)
    xb = jnp.concatenate([hf, jnp.zeros((1, D), dt)], axis=0)[buf_tok].reshape(n_blk, MOE_BLOCK, D)

    def expert_block(args):
        xi, e = args
        return (jax.nn.silu(xi @ w1[e]) * (xi @ w3[e])) @ w2[e]

    yb = lax.map(expert_block, (xb, blk_e)).reshape(P, D)
    out = jnp.zeros((N + 1, D), dt).at[buf_tok].add((yb.astype(jnp.float32) * buf_w[:, None]).astype(dt))
    return out[:N].reshape(B, T, D)


def setup_inputs(seed: int = 0) -> dict:
    key = jax.random.key(seed)
    keys = jax.random.split(key, 32)
    ki = iter(range(32))
    D, dh = D_MODEL, HEAD_DIM
    NE, NO = (DEPTH + 1) // 2, DEPTH // 2

    def normal(shape, scale):
        return scale * jax.random.normal(keys[next(ki)], shape, jnp.float32)

    def gain(shape):
        return 1.0 + 0.05 * jax.random.normal(keys[next(ki)], shape, jnp.float32)

    x = normal((BATCH, SEQ, D), 1.0)
    mem = normal((BATCH, MEM_LEN, D), 1.0)
    norm_g = gain((DEPTH, 4, D))
    ev_w_in = normal((NE, D, EVEN_IN), D ** -0.5)
    ev_w_out = normal((NE, MIX_WIDTH, D), MIX_WIDTH ** -0.5)
    nsa_qk_g = gain((NE, 4, dh))
    nsa_cmp_pe = normal((NE, 2, NSA_CMP_LEN, dh), 0.2)
    nsa_cmp_w1 = normal((NE, 2, NSA_CMP_LEN * dh, NSA_CMP_HIDDEN), (NSA_CMP_LEN * dh) ** -0.5)
    nsa_cmp_w2 = normal((NE, 2, NSA_CMP_HIDDEN, dh), NSA_CMP_HIDDEN ** -0.5)
    diff_qk_g = gain((NE, 2, dh))
    diff_lam = normal((NE, 4, dh), 0.1)
    diff_sub_g = gain((NE, DIFF_VDIM))
    od_w_in = jnp.concatenate([normal((NO, D, 3 * FOX_WIDTH), D ** -0.5),
                               normal((NO, D, FOX_HEADS), 0.1 * D ** -0.5)], axis=-1)
    od_w_out = normal((NO, FOX_WIDTH, D), FOX_WIDTH ** -0.5)
    fox_f_b = jax.random.uniform(keys[next(ki)], (NO, FOX_HEADS), jnp.float32, 1.0, 5.0)
    fox_qk_g = gain((NO, 2, dh))
    ca_wq = normal((DEPTH, D, MEM_WIDTH), D ** -0.5)
    ca_wkv = normal((DEPTH, D, 2 * MEM_WIDTH), D ** -0.5)
    ca_qk_g = gain((DEPTH, 2, dh))
    ca_wo = normal((DEPTH, MEM_WIDTH, D), MEM_WIDTH ** -0.5)
    moe_wg = normal((DEPTH, D, N_GROUPS), D ** -0.5)
    moe_bg = normal((DEPTH, N_GROUPS), 0.01)
    moe_we = normal((DEPTH, D, N_EXPERTS), D ** -0.5)
    moe_be = normal((DEPTH, N_EXPERTS), 0.01)
    moe_w1 = normal((DEPTH, N_EXPERTS, D, EXPERT_FF), D ** -0.5)
    moe_w3 = normal((DEPTH, N_EXPERTS, D, EXPERT_FF), D ** -0.5)
    moe_w2 = normal((DEPTH, N_EXPERTS, EXPERT_FF, D), EXPERT_FF ** -0.5)
    return {'x': x, 'mem': mem, 'norm_g': norm_g, 'ev_w_in': ev_w_in, 'ev_w_out': ev_w_out,
            'nsa_qk_g': nsa_qk_g, 'nsa_cmp_pe': nsa_cmp_pe, 'nsa_cmp_w1': nsa_cmp_w1,
            'nsa_cmp_w2': nsa_cmp_w2, 'diff_qk_g': diff_qk_g, 'diff_lam': diff_lam,
            'diff_sub_g': diff_sub_g, 'od_w_in': od_w_in, 'od_w_out': od_w_out, 'fox_f_b': fox_f_b,
            'fox_qk_g': fox_qk_g, 'ca_wq': ca_wq, 'ca_wkv': ca_wkv, 'ca_qk_g': ca_qk_g, 'ca_wo': ca_wo,
            'moe_wg': moe_wg, 'moe_bg': moe_bg, 'moe_we': moe_we, 'moe_be': moe_be,
            'moe_w1': moe_w1, 'moe_w3': moe_w3, 'moe_w2': moe_w2}


def reference(x, mem, norm_g, ev_w_in, ev_w_out, nsa_qk_g, nsa_cmp_pe, nsa_cmp_w1, nsa_cmp_w2,
              diff_qk_g, diff_lam, diff_sub_g, od_w_in, od_w_out, fox_f_b, fox_qk_g,
              ca_wq, ca_wkv, ca_qk_g, ca_wo, moe_wg, moe_bg, moe_we, moe_be, moe_w1, moe_w3, moe_w2):
    for layer in range(DEPTH):
        i = layer // 2
        h = rmsnorm(x, norm_g[layer, 0])
        if layer % 2 == 0:
            x = x + even_mixer(h, ev_w_in[i], ev_w_out[i], nsa_qk_g[i], nsa_cmp_pe[i], nsa_cmp_w1[i],
                               nsa_cmp_w2[i], diff_qk_g[i], diff_lam[i], diff_sub_g[i], layer)
        else:
            x = x + odd_mixer(h, od_w_in[i], od_w_out[i], fox_f_b[i], fox_qk_g[i])
        x = x + memory_cross_attention(rmsnorm(x, norm_g[layer, 1]), rmsnorm(mem, norm_g[layer, 2]),
                                       ca_wq[layer], ca_wkv[layer], ca_qk_g[layer], ca_wo[layer])
        x = x + hier_moe(rmsnorm(x, norm_g[layer, 3]), moe_wg[layer], moe_bg[layer], moe_we[layer],
                         moe_be[layer], moe_w1[layer], moe_w3[layer], moe_w2[layer])
    return x
```

```cpp
#include <hip/hip_runtime.h>
#include <cstdio>
#include <cstdint>

#define LAS __attribute__((address_space(3)))
#define GAS __attribute__((address_space(1)))
typedef unsigned short bf16_t;
typedef short bf16x8 __attribute__((ext_vector_type(8)));
typedef short s16x4 __attribute__((ext_vector_type(4)));
typedef float f32x2 __attribute__((ext_vector_type(2)));
typedef float f32x4 __attribute__((ext_vector_type(4)));
typedef float f32x16 __attribute__((ext_vector_type(16)));
typedef unsigned u32x2 __attribute__((ext_vector_type(2)));
typedef unsigned u32x4 __attribute__((ext_vector_type(4)));
typedef unsigned long long u64;

#define LDS_WAIT() asm volatile("s_waitcnt lgkmcnt(0)" ::: "memory")
#define VM_WAIT() asm volatile("s_waitcnt vmcnt(0)" ::: "memory")

constexpr int NB = 4, T = 4096, NTOK = NB * T, DM = 2048, HD = 128;
constexpr float EPS = 1e-6f;
constexpr int LDZ0 = 5888, LDZ1 = 6400;
constexpr int ZQ = 0, ZKV = 1024, ZDQ = 2560, ZDK = 3584, ZDV = 4608, ZG = 5632;
constexpr int Z1Q = 0, Z1K = 2048, Z1V = 4096, Z1F = 6144;
constexpr int NEXP = 32, FF = 512, PMAX = 40960;

constexpr size_t MiB = 1u << 20;
constexpr size_t WS_CTL = 0, CTL_ZERO_BYTES = 1 * MiB;
constexpr size_t WS_ROPE = 1 * MiB, WS_MISC = 3 * MiB, WS_GATES = 4 * MiB, WS_SEL = 6 * MiB, WS_CBUF = 7 * MiB, WS_ROUTE = 8 * MiB;
constexpr size_t WS_KC = 9 * MiB, WS_VC = 9 * MiB + 512 * 1024, WS_HID = 10 * MiB, WS_CAKV = 12 * MiB, WS_MEMN = 16 * MiB;
constexpr size_t WS_W_EVIN = 24 * MiB, WS_W_EVOUT = 47 * MiB, WS_W_CMP1 = 55 * MiB, WS_W_ODIN = 59 * MiB, WS_W_ODOUT = 84 * MiB;
constexpr size_t WS_W_CAQ = 92 * MiB, WS_W_CAKV = 96 * MiB, WS_W_CAO = 104 * MiB, WS_W_RT = 108 * MiB, WS_W_M13 = 110 * MiB, WS_W_M2 = 238 * MiB;
constexpr size_t WS_HB = 302 * MiB, WS_Z = 366 * MiB, WS_XS = WS_Z, WS_ATT = 567 * MiB, WS_YB = WS_ATT;
constexpr size_t WS_OC = WS_ATT, WS_OS = WS_ATT + 32 * MiB, WS_OW = WS_ATT + 64 * MiB, WS_O1 = WS_ATT + 96 * MiB, WS_O2 = WS_ATT + 128 * MiB, WS_OMIX = WS_ATT + 160 * MiB;
constexpr size_t WS_CAQ = 791 * MiB, WS_OCA = 807 * MiB, WS_LOGITS = 823 * MiB, WS_HM = 839 * MiB, WS_END = 879 * MiB;
static_assert((size_t)(NTOK + 32) * LDZ1 * 2 <= 201 * MiB && (size_t)PMAX * DM * 2 <= 201 * MiB, "z / xs region");
constexpr int CW_ERR = 0, CW_BAR = 4096, CW_CNT = 8192;

constexpr int RING_BYTES = 131072, MISC_OFF = RING_BYTES, MOE_OFF = RING_BYTES + 512, LDS_BYTES = 147456;

__device__ __forceinline__ unsigned f2bf(float f) { unsigned u = __builtin_bit_cast(unsigned, f); return (u + 0x7fffu + ((u >> 16) & 1u)) >> 16; }
__device__ __forceinline__ unsigned pk2(float lo, float hi) { return f2bf(lo) | (f2bf(hi) << 16); }
__device__ __forceinline__ float bf2f(unsigned short b) { return __builtin_bit_cast(float, (unsigned)b << 16); }
__device__ __forceinline__ unsigned cvtpk(float lo, float hi) { unsigned r; asm volatile("v_cvt_pk_bf16_f32 %0, %1, %2" : "=v"(r) : "v"(lo), "v"(hi)); return r; }
__device__ __forceinline__ int opaque(int v) { asm volatile("" : "+v"(v)); return v; }
__device__ __forceinline__ float wave_sum(float v) {
#pragma unroll
    for (int o = 1; o < 64; o <<= 1) v += __shfl_xor(v, o);
    return v;
}

#define XB_TMO      128
#define XB_XCNT(j)  (256  + 64 * (j))
#define XB_XSUB(j)  (1280 + 64 * (j))
#define XB_XGEN(j)  (2304 + 64 * (j))
#define XB_TOP      3328
#define XB_TOPGEN   3392
#define XCD_BAR_WORDS 3456
#define XB_SPIN_CAP (1u << 18)
__device__ __forceinline__ unsigned xb_ld(unsigned* p)              { return __hip_atomic_load(p, __ATOMIC_RELAXED, __HIP_MEMORY_SCOPE_AGENT); }
__device__ __forceinline__ unsigned xb_add(unsigned* p, unsigned v) { return __hip_atomic_fetch_add(p, v, __ATOMIC_RELAXED, __HIP_MEMORY_SCOPE_AGENT); }
__device__ __forceinline__ unsigned xb_xcc_id() { return (unsigned)__builtin_amdgcn_s_getreg((3 << 11) | 20) & 0xFu; }
#define XB_SPIN(cond, bar) do { unsigned _sp = 0; while (cond) { __builtin_amdgcn_s_sleep(1); \
    if ((++_sp & 255u) == 0u) { if (xb_ld(&(bar)[XB_TMO])) break; if (_sp > XB_SPIN_CAP) { atomicAdd(&(bar)[XB_TMO], 1u); break; } } } } while (0)
struct XcdBarrier { unsigned* bar; unsigned x; volatile LAS unsigned* st; };
__device__ __forceinline__ XcdBarrier xcd_barrier_post(unsigned* bar, volatile LAS unsigned* st) {
    XcdBarrier b; b.bar = bar; b.x = xb_xcc_id(); b.st = st;
    if (threadIdx.x == 0) (void)xb_add(&bar[XB_XCNT(b.x)], 1u);
    return b;
}
__device__ __forceinline__ void xcd_barrier_complete(unsigned* bar, unsigned x, unsigned& nloc, unsigned& nx) {
    const unsigned G = gridDim.x * gridDim.y * gridDim.z;
    unsigned sum, cnt, mine, sp = 0u;
    for (;;) {
        sum = 0u; cnt = 0u; mine = 0u;
#pragma unroll
        for (unsigned j = 0; j < 16; ++j) { const unsigned c = xb_ld(&bar[XB_XCNT(j)]); sum += c; cnt += (c > 0u) ? 1u : 0u; mine = (j == x) ? c : mine; }
        if (sum == G) break;
        __builtin_amdgcn_s_sleep(1);
        if ((++sp & 255u) == 0u) { if (xb_ld(&bar[XB_TMO])) break; if (sp > XB_SPIN_CAP) { atomicAdd(&bar[XB_TMO], 1u); break; } }
    }
    nloc = mine > 0u ? mine : 1u; nx = cnt > 0u ? cnt : 1u;
}
__device__ __forceinline__ void xcd_barrier(const XcdBarrier& b) {
    asm volatile("s_waitcnt vmcnt(0)" ::: "memory");
    __syncthreads();
    if (threadIdx.x == 0) {
        unsigned* bar = b.bar;
        __builtin_amdgcn_s_waitcnt(0);
        unsigned nloc = b.st[0], nx = b.st[1];
        if (nloc == 0u) { xcd_barrier_complete(bar, b.x, nloc, nx); b.st[0] = nloc; b.st[1] = nx; }
        const unsigned old = xb_add(&bar[XB_XSUB(b.x)], 1u);
        const unsigned gen = old / nloc;
        if (old + 1u == (gen + 1u) * nloc) {
            __builtin_amdgcn_fence(__ATOMIC_RELEASE, "agent");
            asm volatile("s_waitcnt vmcnt(0)" ::: "memory");
            const unsigned og = xb_add(&bar[XB_TOP], 1u);
            const unsigned tg = og / nx;
            if (og + 1u == (tg + 1u) * nx) xb_add(&bar[XB_TOPGEN], 1u);
            else XB_SPIN(xb_ld(&bar[XB_TOPGEN]) == tg, bar);
            __builtin_amdgcn_fence(__ATOMIC_ACQUIRE, "agent");
            xb_add(&bar[XB_XGEN(b.x)], 1u);
            asm volatile("s_waitcnt vmcnt(0)" ::: "memory");
        } else {
            XB_SPIN(xb_ld(&bar[XB_XGEN(b.x)]) == gen, bar);
            __builtin_amdgcn_fence(__ATOMIC_ACQUIRE, "agent");
            asm volatile("s_waitcnt vmcnt(0)" ::: "memory");
        }
    }
    __syncthreads();
}

namespace pg8 {
constexpr int BM = 256, BK = 64, HALF = 128, HTB = HALF * BK * 2, STAGE_BYTES = 8 * HTB, NXCD = 8, WGM = 8;
__host__ __device__ __forceinline__ int lds_byte(int r, int c) { const int st = (r >> 4) * 2 + (c >> 5), rr = r & 15, cc = c & 31, ob = rr * 64 + cc * 2; return st * 1024 + (ob ^ (((ob >> 9) & 1) << 5)); }
__host__ __device__ __forceinline__ void stage_rc(int b, int& R, int& C) { const int st = b / 1024, sb = b % 1024, swz = sb ^ (((sb >> 9) & 1) << 5); R = (st >> 1) * 16 + swz / 64; C = (st & 1) * 32 + (swz % 64) / 2; }
__host__ __device__ __forceinline__ int perm32(int rho) { const int n = rho >> 4, i = rho & 15; return 8 * (i >> 2) + 4 * n + (i & 3); }

struct Unit { const char* a; const char* b; int pm, pn; };
struct Dims { int K; int lda, ldb; int segstride; };

struct DenseOrder {
    const char* A; const char* Bt; size_t tA, tB;
    int nM, nN, nwg, G, c;
    __device__ void init(const void* A_, const void* Bt_, int M, int N, size_t lda, size_t ldb, int G_, int c_) { A = (const char*)A_; Bt = (const char*)Bt_; tA = 256 * lda; tB = 256 * ldb; nM = M / BM; nN = N / BM; nwg = nM * nN; G = G_; c = c_; }
    __device__ bool next(int i, Unit& u) const {
        const long L = (long)i * G + c; if (L >= nwg) return false;
        int wgid = (int)L; { const int q = nwg / NXCD, r = nwg % NXCD, xcd = wgid % NXCD, off = wgid / NXCD; wgid = (xcd < r ? xcd * (q + 1) : r * (q + 1) + (xcd - r) * q) + off; }
        const int nig = WGM * nN, gid = wgid / nig, fm = gid * WGM, gsz = (nM - fm) < WGM ? (nM - fm) : WGM;
        u.pm = fm + ((wgid % nig) % gsz); u.pn = (wgid % nig) / gsz; u.a = A + (size_t)u.pm * tA; u.b = Bt + (size_t)u.pn * tB; return true;
    }
};

template <class Epi, class Sched, bool SEG = false>
__device__ __forceinline__ void gemm_phase(LAS unsigned char* lds, const Dims g, const Sched& S, const Epi& E, const int tid) {
    const int wid = __builtin_amdgcn_readfirstlane(tid >> 6), lane = tid & 63, wr = wid >> 2, wc = wid & 3, fr = lane & 15, fq = lane >> 4;
    const int K = g.K, nt = K / BK;
    unsigned voffA[2], voffB[2];
#pragma unroll
    for (int i = 0; i < 2; ++i) { int R, C; stage_rc(tid * 16 + i * 8192, R, C); const int Rb = Epi::PERM ? ((R & ~31) + perm32(R & 31)) : R;
        voffA[i] = (unsigned)(R * g.lda + C * 2); voffB[i] = (unsigned)(Rb * g.ldb + C * 2); }
    const size_t hstepA = (size_t)HALF * g.lda, hstepB = (size_t)HALF * g.ldb;
    const unsigned ldsw = (unsigned)wid * 1024u;
    const int aoff = lds_byte(wr * 64 + fr, fq * 8), boff = lds_byte(wc * 32 + fr, fq * 8);
#define PG8_KOA(kt) (SEG ? ((size_t)((kt) >> 1) * (size_t)g.segstride + (size_t)((kt) & 1) * 128u) : (size_t)(kt) * 128u)
#define PG8_KOB(kt) ((size_t)(kt) * 128u)
#define PG8_SA(b, h) (((b) * 2 + (h)) * HTB)
#define PG8_SB(b, h) ((4 + (b) * 2 + (h)) * HTB)
#define PG8_STAGE(bufoff, gbase, voff) do { _Pragma("unroll") for (int _i = 0; _i < 2; ++_i) \
        __builtin_amdgcn_global_load_lds((const unsigned*)((const char*)(gbase) + (voff)[_i]), (LAS unsigned*)(lds + (bufoff) + ldsw + _i * 8192), 16, 0, 0); } while (0)
#define PG8_LDA(dst, b, h) do { _Pragma("unroll") for (int m = 0; m < 4; ++m) _Pragma("unroll") for (int k = 0; k < 2; ++k) dst[m][k] = *(const LAS bf16x8*)(lds + PG8_SA(b, h) + aoff + m * 2048 + k * 1024); } while (0)
#define PG8_LDB(dst, b, h) do { _Pragma("unroll") for (int n = 0; n < 2; ++n) _Pragma("unroll") for (int k = 0; k < 2; ++k) dst[n][k] = *(const LAS bf16x8*)(lds + PG8_SB(b, h) + boff + n * 2048 + k * 1024); } while (0)
#define PG8_MMA(ai, bj, At, Bt) do { __builtin_amdgcn_s_setprio(1); _Pragma("unroll") for (int m = 0; m < 4; ++m) _Pragma("unroll") for (int n = 0; n < 2; ++n) _Pragma("unroll") for (int k = 0; k < 2; ++k) \
        acc[ai][bj][m][n] = __builtin_amdgcn_mfma_f32_16x16x32_bf16(Bt[n][k], At[m][k], acc[ai][bj][m][n], 0, 0, 0); __builtin_amdgcn_s_setprio(0); } while (0)
#define PG8_WAIT_V(n) asm volatile("s_waitcnt vmcnt(" #n ")" ::: "memory")
#define PG8_WAIT_L(n) asm volatile("s_waitcnt lgkmcnt(" #n ")" ::: "memory")
#define PG8_BAR __builtin_amdgcn_s_barrier()
#define PG8_SCHED __builtin_amdgcn_sched_barrier(0)
    Unit cur, nxt; int ui = 0;
    if (!S.next(0, cur)) return;
    f32x4 acc[2][2][4][2];
#pragma unroll
    for (int a = 0; a < 2; ++a)
#pragma unroll
        for (int b = 0; b < 2; ++b)
#pragma unroll
            for (int m = 0; m < 4; ++m)
#pragma unroll
                for (int n = 0; n < 2; ++n) acc[a][b][m][n] = (f32x4){0.f, 0.f, 0.f, 0.f};
    bf16x8 At[4][2], B0[2][2], B1[2][2];
    const char* cA = cur.a; const char* cB = cur.b;
    PG8_STAGE(PG8_SB(0, 0), cB, voffB); PG8_STAGE(PG8_SB(0, 1), cB + hstepB, voffB); PG8_STAGE(PG8_SA(0, 0), cA, voffA); PG8_STAGE(PG8_SA(0, 1), cA + hstepA, voffA);
    if (wr == 1) PG8_BAR;
    PG8_WAIT_V(2); PG8_BAR;
    PG8_STAGE(PG8_SB(1, 0), cB + PG8_KOB(1), voffB); PG8_STAGE(PG8_SA(1, 0), cA + PG8_KOA(1), voffA); PG8_STAGE(PG8_SB(1, 1), cB + hstepB + PG8_KOB(1), voffB);
    PG8_WAIT_V(6); PG8_BAR;
    for (;;) {
        const bool has_next = S.next(ui + 1, nxt);
        const char* nA = has_next ? nxt.a : cA; const char* nB = has_next ? nxt.b : cB;
        for (int t = 0; t < nt; t += 2) {
            const bool last = (t == nt - 2);
            const char* a1 = cA + PG8_KOA(t + 1);
            const char* bA2 = last ? nA : cA; const char* bB2 = last ? nB : cB; const int kt2 = last ? 0 : t + 2;
            const char* a2 = bA2 + PG8_KOA(kt2); const char* b2 = bB2 + PG8_KOB(kt2);
            const char* a3 = bA2 + PG8_KOA(kt2 + 1); const char* b3 = bB2 + PG8_KOB(kt2 + 1);
            PG8_LDB(B0, 0, 0); PG8_LDB(B1, 0, 1); PG8_SCHED; PG8_LDA(At, 0, 0); PG8_STAGE(PG8_SA(1, 1), a1 + hstepA, voffA);
            PG8_WAIT_V(8); PG8_WAIT_L(0); PG8_BAR; PG8_MMA(0, 0, At, B0); PG8_MMA(0, 1, At, B1); PG8_BAR; PG8_SCHED;
            PG8_LDA(At, 0, 1); PG8_STAGE(PG8_SB(0, 0), b2, voffB); PG8_STAGE(PG8_SB(0, 1), b2 + hstepB, voffB); PG8_STAGE(PG8_SA(0, 0), a2, voffA);
            PG8_WAIT_V(8); PG8_WAIT_L(0); PG8_BAR; PG8_MMA(1, 0, At, B0); PG8_MMA(1, 1, At, B1); PG8_BAR; PG8_SCHED;
            PG8_LDB(B0, 1, 0); PG8_LDB(B1, 1, 1); PG8_SCHED; PG8_LDA(At, 1, 0); PG8_STAGE(PG8_SA(0, 1), a2 + hstepA, voffA);
            PG8_WAIT_V(8); PG8_WAIT_L(0); PG8_BAR; PG8_MMA(0, 0, At, B0); PG8_MMA(0, 1, At, B1); PG8_BAR; PG8_SCHED;
            PG8_LDA(At, 1, 1); PG8_STAGE(PG8_SB(1, 0), b3, voffB); PG8_STAGE(PG8_SB(1, 1), b3 + hstepB, voffB); PG8_STAGE(PG8_SA(1, 0), a3, voffA);
            PG8_WAIT_V(8); PG8_WAIT_L(0); PG8_BAR; PG8_MMA(1, 0, At, B0); PG8_MMA(1, 1, At, B1); PG8_BAR; PG8_SCHED;
        }
        if (wr == 0) PG8_BAR;
        E(acc, cur, wr, wc, fr, fq);
        if (!has_next) break;
#pragma unroll
        for (int a = 0; a < 2; ++a)
#pragma unroll
            for (int b = 0; b < 2; ++b)
#pragma unroll
                for (int m = 0; m < 4; ++m)
#pragma unroll
                    for (int n = 0; n < 2; ++n) acc[a][b][m][n] = (f32x4){0.f, 0.f, 0.f, 0.f};
        cur = nxt; cA = nA; cB = nB; ++ui;
        if (wr == 1) PG8_BAR;
    }
    PG8_WAIT_V(0);
    PG8_BAR;
#undef PG8_KOA
#undef PG8_KOB
#undef PG8_SA
#undef PG8_SB
#undef PG8_STAGE
#undef PG8_LDA
#undef PG8_LDB
#undef PG8_MMA
#undef PG8_WAIT_V
#undef PG8_WAIT_L
#undef PG8_BAR
#undef PG8_SCHED
}
}

namespace pg8 {
struct EpiBf16 {
    static constexpr bool PERM = true;
    bf16_t* O; int ldc;
    __device__ __forceinline__ void operator()(const f32x4 (&acc)[2][2][4][2], const Unit& u, int wr, int wc, int fr, int fq) const {
        const int row0 = u.pm * BM + wr * 64 + fr, col0 = u.pn * BM + wc * 32 + 8 * fq;
#pragma unroll
        for (int ai = 0; ai < 2; ++ai)
#pragma unroll
            for (int m = 0; m < 4; ++m) { bf16_t* rowp = O + (size_t)(row0 + ai * HALF + m * 16) * ldc + col0;
#pragma unroll
                for (int bj = 0; bj < 2; ++bj) { const f32x4 v0 = acc[ai][bj][m][0], v1 = acc[ai][bj][m][1];
                    u32x4 w; w.x = cvtpk(v0[0], v0[1]); w.y = cvtpk(v0[2], v0[3]); w.z = cvtpk(v1[0], v1[1]); w.w = cvtpk(v1[2], v1[3]);
                    *(u32x4*)(rowp + bj * HALF) = w; } }
    }
};
struct EpiF32 {
    static constexpr bool PERM = false;
    float* C; const float* R; int ldc;
    __device__ __forceinline__ void operator()(const f32x4 (&acc)[2][2][4][2], const Unit& u, int wr, int wc, int fr, int fq) const {
        const int row0 = u.pm * BM + wr * 64 + fr, col0 = u.pn * BM + wc * 32 + 4 * fq;
#pragma unroll
        for (int ai = 0; ai < 2; ++ai)
#pragma unroll
            for (int m = 0; m < 4; ++m) { const size_t ro = (size_t)(row0 + ai * HALF + m * 16) * ldc + col0;
#pragma unroll
                for (int bj = 0; bj < 2; ++bj)
#pragma unroll
                    for (int n = 0; n < 2; ++n) { f32x4 v = acc[ai][bj][m][n]; if (R) v += *(const f32x4*)(R + ro + bj * HALF + n * 16); *(f32x4*)(C + ro + bj * HALF + n * 16) = v; } }
    }
};
struct EpiGelu {
    static constexpr bool PERM = true;
    bf16_t* O; const float* bias;
    __device__ __forceinline__ void operator()(const f32x4 (&acc)[2][2][4][2], const Unit& u, int wr, int wc, int fr, int fq) const {
        const int row0 = u.pm * BM + wr * 64 + fr, col0 = wc * 32 + 8 * fq;
        bf16_t* Ob = O + (size_t)u.pn * 2048 * 256; const float* bb = bias + u.pn * 256;
#pragma unroll
        for (int ai = 0; ai < 2; ++ai)
#pragma unroll
            for (int m = 0; m < 4; ++m) { bf16_t* rowp = Ob + (size_t)(row0 + ai * HALF + m * 16) * 256 + col0;
#pragma unroll
                for (int bj = 0; bj < 2; ++bj) { float v[8];
#pragma unroll
                    for (int n = 0; n < 2; ++n) { const f32x4 bv = *(const f32x4*)(bb + col0 + bj * HALF + 4 * n);
#pragma unroll
                        for (int j = 0; j < 4; ++j) { const float x = acc[ai][bj][m][n][j] + bv[j]; const float uu = 1.5957691216f * (x + 0.044715f * x * x * x); v[4 * n + j] = x / (1.0f + __expf(-uu)); } }
                    u32x4 w; w.x = cvtpk(v[0], v[1]); w.y = cvtpk(v[2], v[3]); w.z = cvtpk(v[4], v[5]); w.w = cvtpk(v[6], v[7]);
                    *(u32x4*)(rowp + bj * HALF) = w; } }
    }
};
struct EpiSwiglu {
    static constexpr bool PERM = true;
    bf16_t* O;
    __device__ __forceinline__ void operator()(const f32x4 (&acc)[2][2][4][2], const Unit& u, int wr, int wc, int fr, int fq) const {
        const int row0 = u.pm * BM + wr * 64 + fr, col0 = u.pn * HALF + wc * 32 + 8 * fq;
#pragma unroll
        for (int ai = 0; ai < 2; ++ai)
#pragma unroll
            for (int m = 0; m < 4; ++m) { bf16_t* rowp = O + (size_t)(row0 + ai * HALF + m * 16) * FF + col0; float v[8];
#pragma unroll
                for (int n = 0; n < 2; ++n)
#pragma unroll
                    for (int j = 0; j < 4; ++j) { const float a = acc[ai][0][m][n][j], b = acc[ai][1][m][n][j]; v[4 * n + j] = a / (1.0f + __expf(-a)) * b; }
                u32x4 w; w.x = cvtpk(v[0], v[1]); w.y = cvtpk(v[2], v[3]); w.z = cvtpk(v[4], v[5]); w.w = cvtpk(v[6], v[7]);
                *(u32x4*)rowp = w; }
    }
};
}

namespace att {
constexpr float SCALE = 0.08838834764831845f, THR = 8.f;
constexpr int KVBLK = 64, SHM_V = 16384, SHM_K = 16384;
constexpr int ATT_SCR = 65536, ATT_CST = 65536 + 2048, ATT_IMP = 65536 + 4096;
#define KSWZ(row, colB) ((row) * 256 + ((colB) ^ (((row) & 7) << 4)))
#define SBAR() __builtin_amdgcn_sched_barrier(0)
__device__ __forceinline__ int v_st(int k, int c) { const int kk = (k & ~0xC) | ((k & 4) << 1) | ((k & 8) >> 1); return ((kk >> 3) * 4 + (c >> 5)) * 512 + ((kk & 7) * 32 + (c & 31)) * 2; }
__device__ __forceinline__ int v_rd_base(int lane) { return ((lane & 3) << 3) | (((lane >> 2) & 3) << 6) | (((lane >> 4) & 1) << 5) | (((lane >> 5) & 1) << 8); }
constexpr int v_rd_off(int d0, int ks, int half) { return d0 * 512 + ks * 4096 + half * 2048; }
__device__ __forceinline__ int crow(int r, int hi) { return (r & 3) + 8 * (r >> 2) + 4 * hi; }
__device__ __forceinline__ void mask_tile(f32x16& p0, f32x16& p1, int dq, unsigned W) {
    const float NEG = -__builtin_inff();
#pragma unroll
    for (int r = 0; r < 16; ++r) {
        const int c = (r & 3) + 8 * (r >> 2);
        if ((unsigned)(dq - c) >= W) p0[r] = NEG;
        if ((unsigned)(dq - c - 32) >= W) p1[r] = NEG;
    }
}
__device__ __forceinline__ void partialSM(f32x16& p0, f32x16& p1, float& m_reg, float& mn, float& alpha) {
    float pmax = p0[0];
#pragma unroll
    for (int r = 1; r < 16; ++r) pmax = fmaxf(pmax, p0[r]);
#pragma unroll
    for (int r = 0; r < 16; ++r) pmax = fmaxf(pmax, p1[r]);
    { auto rr = __builtin_amdgcn_permlane32_swap(__float_as_uint(pmax), __float_as_uint(pmax), false, false);
      pmax = fmaxf(__uint_as_float(rr[0]), __uint_as_float(rr[1])); }
    constexpr float C2 = 1.4426950408889634f * SCALE;
    if (__builtin_expect(__all((pmax - m_reg) * SCALE <= THR), 1)) { mn = m_reg; alpha = 1.f; }
    else { mn = fmaxf(m_reg, pmax); alpha = __builtin_amdgcn_exp2f((m_reg - mn) * C2); m_reg = mn; }
    const float mnL = -mn * C2;
#pragma unroll
    for (int r = 0; r < 16; ++r) p0[r] = fmaf(p0[r], C2, mnL);
#pragma unroll
    for (int r = 0; r < 16; ++r) p1[r] = fmaf(p1[r], C2, mnL);
#pragma unroll
    for (int r = 0; r < 16; ++r) p0[r] = __builtin_amdgcn_exp2f(p0[r]);
}
__device__ __forceinline__ void finishSM(f32x16& p0, f32x16& p1, float alpha, float& l_reg, bf16x8& pa0, bf16x8& pa1, bf16x8& pa2, bf16x8& pa3) {
#pragma unroll
    for (int r = 0; r < 16; ++r) p1[r] = __builtin_amdgcn_exp2f(p1[r]);
    float ps = 0;
#pragma unroll
    for (int r = 0; r < 16; ++r) ps += p0[r];
#pragma unroll
    for (int r = 0; r < 16; ++r) ps += p1[r];
    { auto rr = __builtin_amdgcn_permlane32_swap(__float_as_uint(ps), __float_as_uint(ps), false, false);
      ps = __uint_as_float(rr[0]) + __uint_as_float(rr[1]); }
    l_reg = l_reg * alpha + ps;
#define PK4(P, B_, OUT) do { unsigned a0 = cvtpk(P[B_+0], P[B_+1]), a1 = cvtpk(P[B_+2], P[B_+3]);                          \
        unsigned b0 = cvtpk(P[B_+4], P[B_+5]), b1 = cvtpk(P[B_+6], P[B_+7]);                                             \
        auto r0 = __builtin_amdgcn_permlane32_swap(a0, b0, false, false); auto r1 = __builtin_amdgcn_permlane32_swap(a1, b1, false, false); \
        u32x4 w = {r0[0], r1[0], r0[1], r1[1]}; OUT = *reinterpret_cast<bf16x8*>(&w); } while (0)
    PK4(p0, 0, pa0); PK4(p0, 8, pa1); PK4(p1, 0, pa2); PK4(p1, 8, pa3);
#undef PK4
}
template <int KB>
__device__ __forceinline__ void qkt(f32x16& p0, f32x16& p1, const char* K_lds, int r32, int hi, const bf16x8* qr) {
    p0 = f32x16{}; p1 = f32x16{};
    const char* kb[4];
#pragma unroll
    for (int dd = 0; dd < 4; ++dd) kb[dd] = K_lds + KB * SHM_K + KSWZ(r32, (dd * 16 + hi * 8) * 2);
#pragma unroll
    for (int d0 = 0; d0 < 8; ++d0) { const char* a = kb[d0 & 3] + (d0 >> 2) * 128;
        bf16x8 b0 = *reinterpret_cast<const bf16x8*>(a);
        bf16x8 b1 = *reinterpret_cast<const bf16x8*>(a + 32 * 256);
        p0 = __builtin_amdgcn_mfma_f32_32x32x16_bf16(b0, qr[d0], p0, 0, 0, 0);
        p1 = __builtin_amdgcn_mfma_f32_32x32x16_bf16(b1, qr[d0], p1, 0, 0, 0); }
}
template <int VB>
__device__ __forceinline__ void pv_tile(f32x16* o, int vb0, bf16x8 pa0, bf16x8 pa1, bf16x8 pa2, bf16x8 pa3) {
#define TRRD(dst, off) asm volatile("ds_read_b64_tr_b16 %0, %1 offset:%2" : "=&v"(dst) : "v"(vb0), "i"(off) : "memory")
#define PV_D0(d0) do { s16x4 l0, l1, l2, l3, h0, h1, h2, h3; constexpr int b_ = VB * SHM_V + v_rd_off(d0, 0, 0); \
        TRRD(l0, b_); TRRD(h0, b_ + 2048); TRRD(l1, b_ + 4096); TRRD(h1, b_ + 6144); TRRD(l2, b_ + 8192); TRRD(h2, b_ + 10240); TRRD(l3, b_ + 12288); TRRD(h3, b_ + 14336); \
        asm volatile("s_waitcnt lgkmcnt(0)" ::: "memory"); SBAR();   \
        o[d0] = __builtin_amdgcn_mfma_f32_32x32x16_bf16(pa0, (bf16x8){l0[0], l0[1], l0[2], l0[3], h0[0], h0[1], h0[2], h0[3]}, o[d0], 0, 0, 0);   \
        o[d0] = __builtin_amdgcn_mfma_f32_32x32x16_bf16(pa1, (bf16x8){l1[0], l1[1], l1[2], l1[3], h1[0], h1[1], h1[2], h1[3]}, o[d0], 0, 0, 0);   \
        o[d0] = __builtin_amdgcn_mfma_f32_32x32x16_bf16(pa2, (bf16x8){l2[0], l2[1], l2[2], l2[3], h2[0], h2[1], h2[2], h2[3]}, o[d0], 0, 0, 0);   \
        o[d0] = __builtin_amdgcn_mfma_f32_32x32x16_bf16(pa3, (bf16x8){l3[0], l3[1], l3[2], l3[3], h3[0], h3[1], h3[2], h3[3]}, o[d0], 0, 0, 0); } while (0)
    PV_D0(0); PV_D0(1); PV_D0(2); PV_D0(3);
#undef PV_D0
#undef TRRD
}

enum { M_CAUSAL = 0, M_FOX = 1, M_WIN = 2, M_SLC = 3, M_NONE = 4, M_CMP = 5 };
struct AttnArgs {
    const bf16_t* Q; const bf16_t* K; const bf16_t* V; bf16_t* O;
    int ldq, ldk, ldv, ldo;
    int P0, j_lo, j_hi;
    const float* cb;
    const u64* sel;
    const float* qg;
};
__device__ __forceinline__ bf16x8 ovl_frag(int j, int ks, int hi, int r32, int d0p) {
    const int jrel = (32 * d0p + r32) - 2 * (8 * j + 2 * ks + hi);
    const unsigned e0 = (jrel == 0) ? 0x3F80u : 0u, e3 = (jrel == 0 || jrel == 1) ? 0x3F00u : 0u, e4 = (jrel == 1) ? 0x3F80u : 0u, e7 = (jrel == 1 || jrel == 2) ? 0x3F00u : 0u;
    u32x4 w = {e0 | (e0 << 16), e0 | (e3 << 16), e4 | (e4 << 16), e4 | (e7 << 16)};
    return *reinterpret_cast<bf16x8*>(&w);
}

template <int MODE>
__device__ __forceinline__ void attn_block(char* lds, const AttnArgs& a, const int tid) {
    const int wid = __builtin_amdgcn_readfirstlane(tid >> 6), lane = tid & 63, r32 = lane & 31, hi = lane >> 5;
    const int NT = a.j_hi - a.j_lo;
    char* V_lds = lds; char* K_lds = lds + 2 * SHM_V;
    float* ws = (float*)(lds + ATT_SCR) + wid * 64; float* li_l = ws; float* al_l = ws + 32;
    float* cst = (float*)(lds + ATT_CST);
    const int qrow = (MODE == M_CMP) ? (8 * wid + (r32 & 7)) : (32 * wid + r32);
    const int qcol = (MODE == M_CMP) ? ((r32 >> 3) * HD) : 0;
    const int qpos = a.P0 + qrow;
    const int qlo = a.P0 + ((MODE == M_CMP) ? 8 * wid : 32 * wid);
    bf16x8 qr[8];
    { const bf16_t* qp = a.Q + (size_t)qrow * a.ldq + qcol + hi * 8;
#pragma unroll
      for (int d0 = 0; d0 < 8; ++d0) qr[d0] = *reinterpret_cast<const bf16x8*>(qp + d0 * 16); }
    if constexpr (MODE == M_NONE) {
        float ss = 0.f;
#pragma unroll
        for (int d0 = 0; d0 < 8; ++d0)
#pragma unroll
            for (int j = 0; j < 8; ++j) { const float f = bf2f((unsigned short)qr[d0][j]); ss += f * f; }
        { auto rr = __builtin_amdgcn_permlane32_swap(__float_as_uint(ss), __float_as_uint(ss), false, false); ss = __uint_as_float(rr[0]) + __uint_as_float(rr[1]); }
        const float rstd = rsqrtf(ss * (1.0f / HD) + EPS);
#pragma unroll
        for (int d0 = 0; d0 < 8; ++d0) { const f32x4 g0 = *(const f32x4*)(a.qg + d0 * 16 + hi * 8), g1 = *(const f32x4*)(a.qg + d0 * 16 + hi * 8 + 4);
            float f[8];
#pragma unroll
            for (int j = 0; j < 8; ++j) f[j] = bf2f((unsigned short)qr[d0][j]) * rstd * (j < 4 ? g0[j] : g1[j - 4]);
            u32x4 w = {cvtpk(f[0], f[1]), cvtpk(f[2], f[3]), cvtpk(f[4], f[5]), cvtpk(f[6], f[7])}; qr[d0] = *reinterpret_cast<bf16x8*>(&w); }
    }
    float cq_s = 0.f; unsigned sel_lo = 0, sel_hi = 0;
    if constexpr (MODE == M_FOX) cq_s = a.cb[qpos] * (1.0f / SCALE);
    if constexpr (MODE == M_SLC) { const u64 s = a.sel[qpos]; sel_lo = (unsigned)s; sel_hi = (unsigned)(s >> 32); }
    const int sr = tid >> 4, sc = (tid & 15) * 8, vst0 = v_st(sr, sc), vst1 = v_st(32 + sr, sc), kws = KSWZ(sr, sc * 2);
    const int vb0 = (int)(uintptr_t)V_lds + v_rd_base(lane);
    bf16x8 st_v0, st_v1, st_k0, st_k1; float st_c = 0.f;
#define SLOAD(k0) do { st_v0 = *reinterpret_cast<const bf16x8*>(a.V + (size_t)((k0) + sr) * a.ldv + sc); st_v1 = *reinterpret_cast<const bf16x8*>(a.V + (size_t)((k0) + 32 + sr) * a.ldv + sc); \
                       st_k0 = *reinterpret_cast<const bf16x8*>(a.K + (size_t)((k0) + sr) * a.ldk + sc); st_k1 = *reinterpret_cast<const bf16x8*>(a.K + (size_t)((k0) + 32 + sr) * a.ldk + sc); \
                       if constexpr (MODE == M_FOX) { if (tid < 64) st_c = a.cb[(k0) + tid]; } } while (0)
#define SWRITE(bf) do { *(bf16x8*)(V_lds + (bf) * SHM_V + vst0) = st_v0; *(bf16x8*)(V_lds + (bf) * SHM_V + vst1) = st_v1; \
                        *(bf16x8*)(K_lds + (bf) * SHM_K + kws) = st_k0; *(bf16x8*)(K_lds + (bf) * SHM_K + kws + 32 * 256) = st_k1; \
                        if constexpr (MODE == M_FOX) { if (tid < 64) cst[(bf) * 64 + tid] = st_c * (1.0f / SCALE); } } while (0)
    float m_reg = -1e30f, l_reg = 0.f; f32x16 o[4] = {}; f32x16 oi[2] = {};
    f32x16 p0, p1; float mn, alpha; bf16x8 pa0, pa1, pa2, pa3;
#define RESC(al) do { if (__any((al) < 1.f)) { if (hi == 0) al_l[r32] = (al); asm volatile("s_waitcnt lgkmcnt(0)" ::: "memory");              \
                     _Pragma("unroll") for (int r = 0; r < 16; ++r) { const float f_ = al_l[crow(r, hi)]; _Pragma("unroll") for (int d_ = 0; d_ < 4; ++d_) o[d_][r] *= f_; \
                        if constexpr (MODE == M_CMP) { oi[0][r] *= f_; oi[1][r] *= f_; } } } } while (0)
#define STEP(t, KB) do { \
        const int jt_ = a.j_lo + (t), kb_ = jt_ * KVBLK;                                                                              \
        SBAR(); qkt<KB>(p0, p1, K_lds, r32, hi, qr);                                                                                   \
        if ((t) + 1 < NT) { SLOAD(kb_ + KVBLK); }                                                                                      \
        if constexpr (MODE == M_FOX) {                                                                                                 \
            _Pragma("unroll") for (int q_ = 0; q_ < 4; ++q_) { const f32x4 c0_ = *(const f32x4*)(cst + (KB) * 64 + 8 * q_ + 4 * hi), c1_ = *(const f32x4*)(cst + (KB) * 64 + 32 + 8 * q_ + 4 * hi); \
                _Pragma("unroll") for (int j_ = 0; j_ < 4; ++j_) { p0[4 * q_ + j_] += cq_s - c0_[j_]; p1[4 * q_ + j_] += cq_s - c1_[j_]; } } }           \
        if constexpr (MODE == M_CAUSAL || MODE == M_FOX || MODE == M_SLC) { if (kb_ + KVBLK - 1 > qlo) mask_tile(p0, p1, qpos - 4 * hi - kb_, 0x7fffffffu); } \
        if constexpr (MODE == M_WIN) { if (kb_ + KVBLK - 1 > qlo || kb_ <= qlo + 31 - 512) mask_tile(p0, p1, qpos - 4 * hi - kb_, 512u); }      \
        if constexpr (MODE == M_CMP) { mask_tile(p0, p1, ((qpos - 31) >> 4) - 4 * hi - kb_, 0x80000000u); }                            \
        if constexpr (MODE == M_SLC) { const unsigned w_ = (jt_ < 32) ? sel_lo : sel_hi; if (((w_ >> (jt_ & 31)) & 1u) == 0u) {        \
                const float NEG_ = -__builtin_inff(); _Pragma("unroll") for (int r = 0; r < 16; ++r) { p0[r] = NEG_; p1[r] = NEG_; } } } \
        partialSM(p0, p1, m_reg, mn, alpha); finishSM(p0, p1, alpha, l_reg, pa0, pa1, pa2, pa3);                                       \
        RESC(alpha); SBAR();                                                                                                           \
        pv_tile<KB>(o, vb0, pa0, pa1, pa2, pa3);                                                                                       \
        if constexpr (MODE == M_CMP) {                                                                                                 \
            oi[0] = __builtin_amdgcn_mfma_f32_32x32x16_bf16(pa0, ovl_frag(jt_, 0, hi, r32, 0), oi[0], 0, 0, 0); oi[1] = __builtin_amdgcn_mfma_f32_32x32x16_bf16(pa0, ovl_frag(jt_, 0, hi, r32, 1), oi[1], 0, 0, 0); \
            oi[0] = __builtin_amdgcn_mfma_f32_32x32x16_bf16(pa1, ovl_frag(jt_, 1, hi, r32, 0), oi[0], 0, 0, 0); oi[1] = __builtin_amdgcn_mfma_f32_32x32x16_bf16(pa1, ovl_frag(jt_, 1, hi, r32, 1), oi[1], 0, 0, 0); \
            oi[0] = __builtin_amdgcn_mfma_f32_32x32x16_bf16(pa2, ovl_frag(jt_, 2, hi, r32, 0), oi[0], 0, 0, 0); oi[1] = __builtin_amdgcn_mfma_f32_32x32x16_bf16(pa2, ovl_frag(jt_, 2, hi, r32, 1), oi[1], 0, 0, 0); \
            oi[0] = __builtin_amdgcn_mfma_f32_32x32x16_bf16(pa3, ovl_frag(jt_, 3, hi, r32, 0), oi[0], 0, 0, 0); oi[1] = __builtin_amdgcn_mfma_f32_32x32x16_bf16(pa3, ovl_frag(jt_, 3, hi, r32, 1), oi[1], 0, 0, 0); } \
        if ((t) + 1 < NT) { VM_WAIT(); SWRITE((KB) ^ 1); }                                                                             \
        __syncthreads(); } while (0)
    SLOAD(a.j_lo * KVBLK); VM_WAIT(); SWRITE(0); __syncthreads();
    int t = 0;
    for (; t + 1 < NT; t += 2) { STEP(t, 0); STEP(t + 1, 1); }
    if (NT & 1) { STEP(NT - 1, 0); }
    if (hi == 0) li_l[r32] = l_reg; asm volatile("s_waitcnt lgkmcnt(0)" ::: "memory");
    float rli[16];
#pragma unroll
    for (int r = 0; r < 16; ++r) rli[r] = __builtin_amdgcn_rcpf(fmaxf(li_l[crow(r, hi)], 1e-30f));
#pragma unroll
    for (int r = 0; r < 16; ++r) { const int orow = crow(r, hi);
        bf16_t* Ow = (MODE == M_CMP) ? a.O + (size_t)(8 * wid + (orow & 7)) * a.ldo + (orow >> 3) * HD : a.O + (size_t)(32 * wid + orow) * a.ldo;
#pragma unroll
        for (int d0 = 0; d0 < 4; ++d0) { const float v = o[d0][r] * rli[r]; const float vn = __shfl_xor(v, 1);
            if ((r32 & 1) == 0) *(unsigned*)(Ow + d0 * 32 + r32) = cvtpk(v, vn); } }
    if constexpr (MODE == M_CMP) {
        float* imp = (float*)(lds + ATT_IMP);
#pragma unroll
        for (int rr = 0; rr < 4; ++rr)
#pragma unroll
            for (int d0p = 0; d0p < 2; ++d0p) { float v = 0.f;
#pragma unroll
                for (int q = 0; q < 4; ++q) v += oi[d0p][4 * q + rr] * rli[4 * q + rr];
                imp[(8 * wid + rr + 4 * hi) * 65 + 32 * d0p + r32] = v; }
        __syncthreads();
        if (tid < 64) { const int pos = a.P0 + tid, qb = pos >> 6; const float* im = imp + tid * 65;
            u64 mask = 1ull | (1ull << qb) | (qb >= 1 ? (1ull << (qb - 1)) : 0ull);
            if (qb - 2 <= 5) { for (int j = 1; j <= qb - 2; ++j) mask |= 1ull << j; }
            else { for (int k = 0; k < 5; ++k) { int best = 1; float bv = -1.f;
                    for (int j = 1; j <= qb - 2; ++j) { const float v = im[j]; if (((mask >> j) & 1ull) == 0ull && v > bv) { bv = v; best = j; } }
                    mask |= 1ull << best; } }
            ((u64*)a.sel)[pos] = mask; }
    }
    __syncthreads();
#undef STEP
#undef RESC
#undef SLOAD
#undef SWRITE
}
}

__device__ __forceinline__ void tr_item(const float* W, int src_ld, int k0, int c0, int nvalid, bf16_t* WT, int dst_ld, int drow0, LAS float* scr, int lane) {
#pragma unroll 8
    for (int i = 0; i < 32; ++i) { const int kk = 2 * i + (lane >> 5), n = lane & 31; scr[kk * 33 + n] = (n < nvalid) ? W[(size_t)(k0 + kk) * src_ld + c0 + n] : 0.f; }
    LDS_WAIT(); asm volatile("" ::: "memory");
    const int c = lane & 7;
#pragma unroll
    for (int j = 0; j < 4; ++j) { const int n = (lane >> 3) + 8 * j; const LAS float* s = scr + (8 * c) * 33 + n;
        u32x4 o; o.x = pk2(s[0 * 33], s[1 * 33]); o.y = pk2(s[2 * 33], s[3 * 33]); o.z = pk2(s[4 * 33], s[5 * 33]); o.w = pk2(s[6 * 33], s[7 * 33]);
        if (n < nvalid) *(u32x4*)(WT + (size_t)(drow0 + n) * dst_ld + k0 + 8 * c) = o; }
    LDS_WAIT(); asm volatile("" ::: "memory");
}
__device__ __forceinline__ void tr_block(const float* W, int src_ld, int K, int c0, int ncols, bf16_t* WT, int drow0, LAS float* scr, int gw, int NGW, int lane) {
    const int nblk = (ncols + 31) >> 5, items = (K >> 6) * nblk;
    for (int it = gw; it < items; it += NGW) { const int kb = it / nblk, nb = it - kb * nblk; const int rem = ncols - 32 * nb;
        tr_item(W, src_ld, 64 * kb, c0 + 32 * nb, rem < 32 ? rem : 32, WT, K, drow0 + 32 * nb, scr, lane); }
}
__device__ __forceinline__ void zero_fill16(void* p, size_t bytes, int gtid, int NGT) {
    u32x4* q = (u32x4*)p; const size_t n = bytes >> 4; const u32x4 z = {0u, 0u, 0u, 0u};
    for (size_t i = gtid; i < n; i += NGT) q[i] = z;
}
__device__ __forceinline__ void moe_convert(const float* w1, const float* w3, const float* w2, bf16_t* W13, bf16_t* W2, LAS float* scr, int gw, int NGW, int lane) {
    for (int it = gw; it < 32768; it += NGW) { const int nb = it & 15, kb = (it >> 4) & 31, which = (it >> 9) & 1, e = it >> 10; const int c0 = nb * 32;
        const float* src = (which ? w3 : w1) + (size_t)e * DM * FF;
        tr_item(src, FF, 64 * kb, c0, 32, W13 + (size_t)e * 1024 * DM, DM, (c0 >> 7) * 256 + which * 128 + (c0 & 127), scr, lane); }
    for (int it = gw; it < 16384; it += NGW) { const int nb = it & 63, kb = (it >> 6) & 7, e = it >> 9;
        tr_item(w2 + (size_t)e * FF * DM, DM, 64 * kb, nb * 32, 32, W2 + (size_t)e * DM * FF, FF, nb * 32, scr, lane); }
}
__device__ __forceinline__ void norm_row(const float* xrow, const float* g, bf16_t* orow, int lane) {
    const f32x4* xr = (const f32x4*)xrow + lane; const f32x4* gr = (const f32x4*)g + lane;
    f32x4 v[8]; float s = 0.f;
#pragma unroll
    for (int j = 0; j < 8; ++j) { v[j] = xr[64 * j]; s += (v[j].x * v[j].x + v[j].y * v[j].y) + (v[j].z * v[j].z + v[j].w * v[j].w); }
    const float rstd = rsqrtf(wave_sum(s) * (1.f / DM) + EPS);
    u32x2* o8 = (u32x2*)orow + lane;
#pragma unroll
    for (int j = 0; j < 8; ++j) { const f32x4 gg = gr[64 * j]; u32x2 w; w.x = pk2(v[j].x * rstd * gg.x, v[j].y * rstd * gg.y); w.y = pk2(v[j].z * rstd * gg.z, v[j].w * rstd * gg.w); o8[64 * j] = w; }
}
template <bool ROPE>
__device__ __forceinline__ void head_norm(bf16_t* p, const float* g, const f32x2* rope_row, int lane) {
    const float x0 = bf2f(p[lane]), x1 = bf2f(p[64 + lane]);
    const float rstd = rsqrtf(wave_sum(x0 * x0 + x1 * x1) * (1.f / HD) + EPS);
    float y0 = x0 * rstd * g[lane], y1 = x1 * rstd * g[64 + lane];
    if constexpr (ROPE) { const f32x2 cs = rope_row[lane]; const float o0 = y0 * cs.x - y1 * cs.y, o1 = y1 * cs.x + y0 * cs.y; y0 = o0; y1 = o1; }
    p[lane] = (bf16_t)f2bf(y0); p[64 + lane] = (bf16_t)f2bf(y1);
}

__device__ __forceinline__ int deal(int i, int G, int c) { return (i & 1) ? i * G + (G - 1 - c) : i * G + c; }

struct MoeOrder {
    const char* A; size_t tA; const char* Bt; size_t eB, tB; int nN, total, G, c; const LAS int* tstart;
    __device__ bool next(int i, pg8::Unit& u) const {
        const int L = i * G + c; if (L >= total) return false;
        const int rt = L / nN, pn = L - rt * nN; int e = 0;
        for (int k = 1; k < NEXP; ++k) e += (tstart[k] <= rt) ? 1 : 0;
        u.a = A + (size_t)rt * tA; u.b = Bt + (size_t)e * eB + (size_t)pn * tB; u.pm = rt; u.pn = pn; return true;
    }
};
struct CaKvOrder {
    const char* A; const char* Bt; int c;
    __device__ bool next(int i, pg8::Unit& u) const {
        if (i > 0 || c >= 32) return false;
        const int ll = c >> 4, pm = (c >> 2) & 3, pn = c & 3;
        u.a = A + ((size_t)ll * 1024 + 256 * pm) * DM * 2; u.b = Bt + ((size_t)ll * 1024 + 256 * pn) * DM * 2; u.pm = ll * 4 + pm; u.pn = pn; return true;
    }
};
struct CmpOrder {
    const char* Z; const char* Bt; int c;
    __device__ bool next(int i, pg8::Unit& u) const {
        if (i > 0 || c >= 16) return false;
        const int kv = c >> 3, bg = c & 7, b = bg >> 1, g = bg & 1;
        u.a = Z + ((size_t)(b * T) * LDZ0 + ZKV + (kv * 2 + g) * HD) * 2; u.b = Bt + (size_t)kv * 256 * 4096 * 2; u.pm = bg; u.pn = kv; return true;
    }
};

#ifndef ROUTE_TAU
#define ROUTE_TAU 0.02f
#endif
struct RouteDec { int grp, j0, j1; float w0, w1, margin; };
__device__ __forceinline__ RouteDec route_decide(const float* lg, const float* bg, const float* be) {
    RouteDec d; float gmax = -3.0e38f, g2 = -3.0e38f; int grp = 0;
    const float gl0 = lg[32] + bg[0], gl1 = lg[33] + bg[1], gl2 = lg[34] + bg[2], gl3 = lg[35] + bg[3];
#define RD_G(v, j) { const bool a_ = (v) > gmax, b_ = (v) > g2; g2 = a_ ? gmax : (b_ ? (v) : g2); grp = a_ ? (j) : grp; gmax = a_ ? (v) : gmax; }
    RD_G(gl0, 0) RD_G(gl1, 1) RD_G(gl2, 2) RD_G(gl3, 3)
#undef RD_G
    const float gsum = __expf(gl0 - gmax) + __expf(gl1 - gmax) + __expf(gl2 - gmax) + __expf(gl3 - gmax);
    const float ptop = 1.f / gsum;
    float v0 = -3.0e38f, v1 = -3.0e38f, v2 = -3.0e38f; int j0 = 0, j1 = 0;
#pragma unroll
    for (int j = 0; j < 8; ++j) { const float v = lg[grp * 8 + j] + be[grp * 8 + j];
        const bool a_ = v > v0, b_ = v > v1, c_ = v > v2;
        v2 = b_ ? v1 : (c_ ? v : v2); j1 = a_ ? j0 : (b_ ? j : j1); v1 = a_ ? v0 : (b_ ? v : v1); j0 = a_ ? j : j0; v0 = a_ ? v : v0; }
    const float e1 = __expf(v1 - v0); d.w0 = ptop / (1.f + e1); d.w1 = ptop * e1 / (1.f + e1);
    d.margin = fminf(gmax - g2, v1 - v2); d.grp = grp; d.j0 = j0; d.j1 = j1; return d;
}
__device__ __forceinline__ void route_commit(int m, int grp, int j0, int j1, float w0, float w1, unsigned* cnt, int* eid, float* wt, int* rank) {
    const int ea = grp * 8 + j0, eb = grp * 8 + j1;
    eid[2 * m] = ea; eid[2 * m + 1] = eb; wt[2 * m] = w0; wt[2 * m + 1] = w1;
    rank[2 * m] = (int)atomicAdd(cnt + ea, 1u); rank[2 * m + 1] = (int)atomicAdd(cnt + eb, 1u);
}

struct Args { const float* in[27]; float* out; unsigned char* ws; int ph_lo, ph_hi; };
enum { I_X = 0, I_MEM, I_NORMG, I_EVIN, I_EVOUT, I_NSAG, I_CMPPE, I_CMPW1, I_CMPW2, I_DIFFG, I_DIFFLAM, I_DIFFSUB, I_ODIN, I_ODOUT, I_FOXB, I_FOXG,
       I_CAWQ, I_CAWKV, I_CAG, I_CAWO, I_MOEWG, I_MOEBG, I_MOEWE, I_MOEBE, I_MOEW1, I_MOEW3, I_MOEW2 };
constexpr int NPHASE = 34;

__device__ __forceinline__ const void* karg_ptr(int byte_off) {
    const __attribute__((address_space(4))) char* kp = (const __attribute__((address_space(4))) char*)__builtin_amdgcn_kernarg_segment_ptr();
    return *(const void* const volatile __attribute__((address_space(4)))*)(kp + byte_off);
}
__device__ __forceinline__ int karg_int(int byte_off) {
    const __attribute__((address_space(4))) char* kp = (const __attribute__((address_space(4))) char*)__builtin_amdgcn_kernarg_segment_ptr();
    return *(const volatile int __attribute__((address_space(4)))*)(kp + byte_off);
}
#define KIN(i) ((const float*)karg_ptr(8 * (i)))
#define PHASE_LOCALS \
    unsigned char* const ws = (unsigned char*)karg_ptr(224); float* const xs = (float*)karg_ptr(216); (void)xs; \
    const int tid = opaque((int)threadIdx.x), lane = tid & 63, wave = __builtin_amdgcn_readfirstlane(tid >> 6); (void)lane; (void)wave; \
    const int G = gridDim.x, bx = blockIdx.x; const int gw = bx * 8 + wave, NGW = G * 8, gtid = bx * 512 + tid, NGT = G * 512; (void)gw; (void)NGW; (void)gtid; (void)NGT; \
    LAS float* const scr = (LAS float*)(ldsl + wave * 16384); (void)scr; LAS int* const tstart = (LAS int*)(ldsl + MOE_OFF); (void)tstart; \
    unsigned* const ctl = (unsigned*)(ws + WS_CTL); (void)ctl
#define x_in KIN(I_X)
#define normg KIN(I_NORMG)
#define HB ((bf16_t*)(ws + WS_HB))
#define Z ((bf16_t*)(ws + WS_Z))
#define ROPE ((const f32x2*)(ws + WS_ROPE))
#define CMPPART ((float*)(ws + WS_MISC))
#define CMPBIAS ((float*)(ws + WS_MISC + 65536))
#define GATES ((float*)(ws + WS_GATES))
#define SEL ((u64*)(ws + WS_SEL))
#define CBUF ((float*)(ws + WS_CBUF))
#define R_EID ((int*)(ws + WS_ROUTE))
#define R_WT ((float*)(ws + WS_ROUTE + 131072))
#define R_RANK ((int*)(ws + WS_ROUTE + 262144))
#define R_SLOT ((int*)(ws + WS_ROUTE + 393216))
#define KC ((bf16_t*)(ws + WS_KC))
#define VC ((bf16_t*)(ws + WS_VC))
#define HID ((bf16_t*)(ws + WS_HID))
#define CAKV ((bf16_t*)(ws + WS_CAKV))
#define MEMN ((bf16_t*)(ws + WS_MEMN))
#define W_EVIN ((bf16_t*)(ws + WS_W_EVIN))
#define W_EVOUT ((bf16_t*)(ws + WS_W_EVOUT))
#define W_CMP1 ((bf16_t*)(ws + WS_W_CMP1))
#define W_ODIN ((bf16_t*)(ws + WS_W_ODIN))
#define W_ODOUT ((bf16_t*)(ws + WS_W_ODOUT))
#define W_CAQ ((bf16_t*)(ws + WS_W_CAQ))
#define W_CAKV ((bf16_t*)(ws + WS_W_CAKV))
#define W_CAO ((bf16_t*)(ws + WS_W_CAO))
#define W_RT ((bf16_t*)(ws + WS_W_RT))
#define W_M13 ((bf16_t*)(ws + WS_W_M13))
#define W_M2 ((bf16_t*)(ws + WS_W_M2))
#define OC ((bf16_t*)(ws + WS_OC))
#define OS ((bf16_t*)(ws + WS_OS))
#define OW ((bf16_t*)(ws + WS_OW))
#define O1 ((bf16_t*)(ws + WS_O1))
#define O2 ((bf16_t*)(ws + WS_O2))
#define OMIX ((bf16_t*)(ws + WS_OMIX))
#define CAQ ((bf16_t*)(ws + WS_CAQ))
#define OCA ((bf16_t*)(ws + WS_OCA))
#define LOGITS ((float*)(ws + WS_LOGITS))
#define XS ((bf16_t*)(ws + WS_XS))
#define HM ((bf16_t*)(ws + WS_HM))
#define YB ((bf16_t*)(ws + WS_YB))

__global__ void __launch_bounds__(512, 2) mk_fwd(Args args) {
    extern __shared__ __attribute__((aligned(16))) unsigned char lds[];
    LAS unsigned char* const ldsl = (LAS unsigned char*)lds;
    { const int t0 = threadIdx.x;
      for (int u = t0; u < (LDS_BYTES - MISC_OFF) / 4; u += 512) ((LAS unsigned*)(ldsl + MISC_OFF))[u] = 0u;
      __syncthreads();
      (void)xcd_barrier_post((unsigned*)((unsigned char*)karg_ptr(224) + WS_CTL) + CW_BAR, (volatile LAS unsigned*)(ldsl + MISC_OFF + 32)); }
    const int lo = karg_int(232), hi = karg_int(236);
#ifndef ONLY
#define ONLY (-1)
#endif
#define PHM(k) (ONLY < 0 || ONLY == (k))
#define IN(k) (PHM(k) && lo <= (k) && (k) < hi)
#define INC(j) (PHM(100 + (j)) && lo <= (cb + (j)) && (cb + (j)) < hi)
#define SEAM(k) do { if (lo <= (k) && (k) + 1 < hi) { XcdBarrier b_; b_.bar = (unsigned*)((unsigned char*)karg_ptr(224) + WS_CTL) + CW_BAR; b_.x = xb_xcc_id(); b_.st = (volatile LAS unsigned*)(ldsl + MISC_OFF + 32); xcd_barrier(b_); } } while (0)

    for (int l = 0; l < 2; ++l) {
      if (l == 0) {
        if (IN(0)) { PHASE_LOCALS;
            const float* ev_in = KIN(I_EVIN);
            tr_block(ev_in, 5656, DM, 0, 2560, W_EVIN, 0, scr, gw, NGW, lane);
            tr_block(ev_in, 5656, DM, 2584, 3072, W_EVIN, 2560, scr, gw, NGW, lane);
            tr_block(ev_in, 5656, DM, 2560, 24, W_EVIN, 5632, scr, gw, NGW, lane);
            zero_fill16(W_EVIN + (size_t)5656 * DM, (size_t)(LDZ0 - 5656) * DM * 2, gtid, NGT);
            tr_block(KIN(I_EVOUT), DM, DM, 0, DM, W_EVOUT, 0, scr, gw, NGW, lane);
            for (int kv = 0; kv < 2; ++kv) tr_block(KIN(I_CMPW1) + (size_t)kv * 4096 * 256, 256, 4096, 0, 256, W_CMP1 + (size_t)kv * 256 * 4096, 0, scr, gw, NGW, lane);
            tr_block(KIN(I_ODIN), 6160, DM, 0, 6160, W_ODIN, 0, scr, gw, NGW, lane);
            zero_fill16(W_ODIN + (size_t)6160 * DM, (size_t)(LDZ1 - 6160) * DM * 2, gtid, NGT);
            tr_block(KIN(I_ODOUT), DM, DM, 0, DM, W_ODOUT, 0, scr, gw, NGW, lane);
            for (int ll = 0; ll < 2; ++ll) {
                tr_block(KIN(I_CAWQ) + (size_t)ll * DM * 512, 512, DM, 0, 512, W_CAQ + (size_t)ll * 512 * DM, 0, scr, gw, NGW, lane);
                tr_block(KIN(I_CAWKV) + (size_t)ll * DM * 1024, 1024, DM, 0, 1024, W_CAKV + (size_t)ll * 1024 * DM, 0, scr, gw, NGW, lane);
                tr_block(KIN(I_CAWO) + (size_t)ll * 512 * DM, DM, 512, 0, DM, W_CAO + (size_t)ll * DM * 512, 0, scr, gw, NGW, lane);
                tr_block(KIN(I_MOEWE) + (size_t)ll * DM * 32, 32, DM, 0, 32, W_RT + (size_t)ll * 256 * DM, 0, scr, gw, NGW, lane);
                tr_block(KIN(I_MOEWG) + (size_t)ll * DM * 4, 4, DM, 0, 4, W_RT + (size_t)ll * 256 * DM, 32, scr, gw, NGW, lane);
                zero_fill16(W_RT + (size_t)ll * 256 * DM + (size_t)36 * DM, (size_t)220 * DM * 2, gtid, NGT);
            }
            moe_convert(KIN(I_MOEW1), KIN(I_MOEW3), KIN(I_MOEW2), W_M13, W_M2, scr, gw, NGW, lane);
            for (int i = gtid; i < T * 64; i += NGT) { const int pos = i >> 6, k = i & 63;
                const float inv = exp2f(-(float)k * (13.287712379549449f / 64.0f)); const float ang = (float)pos * inv;
                const double a = (double)ang, kk = rint(a * 0.15915494309189535); const float r = (float)(a - kk * 6.283185307179586);
                f32x2 cs; cs.x = __cosf(r); cs.y = __sinf(r); ((f32x2*)(ws + WS_ROPE))[i] = cs; }
            for (int tsk = gw; tsk < 256; tsk += NGW) { const int cblk = tsk & 3, chunk = (tsk >> 2) & 31, kv = tsk >> 7; const int c = cblk * 64 + lane;
                const float* pe = KIN(I_CMPPE) + (size_t)kv * 4096 + chunk * 128; const float* w = KIN(I_CMPW1) + (size_t)kv * 4096 * 256 + (size_t)chunk * 128 * 256 + c;
                float s = 0.f;
#pragma unroll 8
                for (int k = 0; k < 128; ++k) s += pe[k] * w[(size_t)k * 256];
                CMPPART[(kv * 32 + chunk) * 256 + c] = s; }
            for (int m = gw; m < NTOK; m += NGW) norm_row(x_in + (size_t)m * DM, normg + 0 * DM, HB + (size_t)m * DM, lane);
            for (int m = gw; m < 2048; m += NGW) { const int ll = m >> 10, r = m & 1023; norm_row(KIN(I_MEM) + (size_t)r * DM, normg + (size_t)(ll * 4 + 2) * DM, MEMN + (size_t)m * DM, lane); }
        }
        SEAM(0);
        if (IN(1)) { PHASE_LOCALS;
            if (bx == 0) { const int kv = tid >> 8, c = tid & 255; float s = 0.f; for (int ch = 0; ch < 32; ++ch) s += CMPPART[(kv * 32 + ch) * 256 + c]; CMPBIAS[kv * 256 + c] = s; }
            { pg8::Dims g{DM, DM * 2, DM * 2, 0}; pg8::DenseOrder S; S.init(HB, W_EVIN, NTOK, LDZ0, DM * 2, DM * 2, G, bx); pg8::EpiBf16 E{Z, LDZ0};
              pg8::gemm_phase<pg8::EpiBf16, pg8::DenseOrder>(ldsl, g, S, E, tid); }
            { pg8::Dims g{DM, DM * 2, DM * 2, 0}; CaKvOrder S{(const char*)MEMN, (const char*)W_CAKV, (bx + 64) & 255}; pg8::EpiBf16 E{CAKV, 1024};
              pg8::gemm_phase<pg8::EpiBf16, CaKvOrder>(ldsl, g, S, E, tid); }
        }
        SEAM(1);
        if (IN(2)) { PHASE_LOCALS;
            { pg8::Dims g{4096, 16 * LDZ0 * 2, 4096 * 2, LDZ0 * 2}; CmpOrder S{(const char*)Z, (const char*)W_CMP1, bx}; pg8::EpiGelu E{HID, CMPBIAS};
              pg8::gemm_phase<pg8::EpiGelu, CmpOrder, true>(ldsl, g, S, E, tid); }
            const float* nsag = KIN(I_NSAG); const float* dg = KIN(I_DIFFG);
            for (int m = gw; m < NTOK; m += NGW) { bf16_t* zr = Z + (size_t)m * LDZ0; const f32x2* rr = ROPE + (size_t)(m & (T - 1)) * 64;
                for (int h = 0; h < 8; ++h) head_norm<true>(zr + ZQ + h * HD, nsag, rr, lane);
                for (int g2 = 0; g2 < 2; ++g2) { head_norm<true>(zr + ZKV + (4 + g2) * HD, nsag + 2 * HD, rr, lane); head_norm<true>(zr + ZKV + (8 + g2) * HD, nsag + 3 * HD, rr, lane); }
                for (int h = 0; h < 8; ++h) { head_norm<true>(zr + ZDQ + h * HD, dg, rr, lane); head_norm<true>(zr + ZDK + h * HD, dg + HD, rr, lane); }
                if (lane < 24) GATES[(size_t)m * 24 + lane] = 1.f / (1.f + __expf(-bf2f(zr[ZG + lane]))); }
            for (int m = gw; m < 2048 * 4; m += NGW) { const int row = m >> 2, h = m & 3, ll = row >> 10; head_norm<false>(CAKV + (size_t)row * 1024 + h * HD, KIN(I_CAG) + (ll * 2 + 1) * HD, nullptr, lane); }
        }
        SEAM(2);
        if (IN(3)) { PHASE_LOCALS;
            for (int m = gw; m < 2 * 2048; m += NGW) { const int kv = m >> 11, row = m & 2047, bg = row >> 8, n = row & 255;
                bf16_t* dst = (kv ? VC : KC) + (size_t)row * HD;
                if (n == 255) { dst[lane] = 0; dst[64 + lane] = 0; continue; }
                const bf16_t* hrow = HID + ((size_t)kv * 2048 + row) * 256; const float* w2 = KIN(I_CMPW2) + (size_t)kv * 256 * HD;
                float hv[4];
#pragma unroll
                for (int j = 0; j < 4; ++j) hv[j] = bf2f(hrow[4 * lane + j]);
                float a0 = 0.f, a1 = 0.f;
                for (int j4 = 0; j4 < 64; ++j4) {
#pragma unroll
                    for (int jj = 0; jj < 4; ++jj) { const float hj = __shfl(hv[jj], j4); const float* wr_ = w2 + (size_t)(4 * j4 + jj) * HD; a0 += hj * wr_[lane]; a1 += hj * wr_[64 + lane]; } }
                if (kv == 0) { const float rstd = rsqrtf(wave_sum(a0 * a0 + a1 * a1) * (1.f / HD) + EPS); const float* gk = KIN(I_NSAG) + HD;
                    const float y0 = a0 * rstd * gk[lane], y1 = a1 * rstd * gk[64 + lane]; const f32x2 cs = ROPE[(size_t)(16 * n + 31) * 64 + lane];
                    a0 = y0 * cs.x - y1 * cs.y; a1 = y1 * cs.x + y0 * cs.y; }
                dst[lane] = (bf16_t)f2bf(a0); dst[64 + lane] = (bf16_t)f2bf(a1); (void)bg; }
        }
        SEAM(3);
        if (IN(4)) { PHASE_LOCALS; const int tq = tid;
            for (int i = 0;; ++i) { const int idx = deal(i, G, bx); if (idx >= 512) break;
                const int tb = 63 - (idx >> 3), rest = idx & 7, b = rest >> 1, g2 = rest & 1, P0 = 64 * tb;
                att::AttnArgs a; a.Q = Z + (size_t)(b * T + P0) * LDZ0 + ZQ + g2 * 4 * HD; a.ldq = LDZ0; a.K = KC + (size_t)(b * 2 + g2) * 256 * HD; a.V = VC + (size_t)(b * 2 + g2) * 256 * HD; a.ldk = HD; a.ldv = HD;
                a.O = OC + (size_t)(b * T + P0) * 1024 + g2 * 4 * HD; a.ldo = 1024; a.P0 = P0; a.j_lo = 0; a.j_hi = (((P0 + 32) >> 4) >> 6) + 1; a.cb = nullptr; a.sel = SEL + (size_t)(b * 2 + g2) * T; a.qg = nullptr;
                att::attn_block<att::M_CMP>((char*)lds, a, tq); }
        }
        SEAM(4);
        if (IN(5)) { PHASE_LOCALS; const int tq = tid;
            for (int i = 0;; ++i) { const int idx = deal(i, G, bx); if (idx >= 2048) break;
                att::AttnArgs a; a.cb = nullptr; a.sel = nullptr; a.qg = nullptr; a.ldq = LDZ0; a.ldk = LDZ0; a.ldv = LDZ0; a.ldo = 1024; a.j_lo = 0;
                if (idx < 1536) { const int qb = 15 - idx / 96, r = idx % 96; a.P0 = qb * 256; a.j_hi = 4 * (qb + 1);
                    if (r < 64) { const int b = r >> 4, h = (r >> 2) & 3, m = (r >> 1) & 1, vh = r & 1; const bf16_t* zb = Z + (size_t)(b * T) * LDZ0;
                        a.Q = zb + (size_t)a.P0 * LDZ0 + ZDQ + (h * 2 + m) * HD; a.K = zb + ZDK + (h * 2 + m) * HD; a.V = zb + ZDV + h * 256 + vh * HD;
                        a.O = (m ? O2 : O1) + (size_t)(b * T + a.P0) * 1024 + h * 256 + vh * HD;
                        att::attn_block<att::M_CAUSAL>((char*)lds, a, tq); }
                    else { const int r2 = r - 64, b = r2 >> 3, hq = r2 & 7, g2 = hq >> 2; const bf16_t* zb = Z + (size_t)(b * T) * LDZ0;
                        a.Q = zb + (size_t)a.P0 * LDZ0 + ZQ + hq * HD; a.K = zb + ZKV + (4 + g2) * HD; a.V = zb + ZKV + (6 + g2) * HD;
                        a.O = OS + (size_t)(b * T + a.P0) * 1024 + hq * HD; a.sel = SEL + (size_t)(b * 2 + g2) * T;
                        att::attn_block<att::M_SLC>((char*)lds, a, tq); } }
                else { const int r = idx - 1536, qb = 15 - (r >> 5), r2 = r & 31, b = r2 >> 3, hq = r2 & 7, g2 = hq >> 2; const bf16_t* zb = Z + (size_t)(b * T) * LDZ0;
                    a.P0 = qb * 256; a.j_hi = 4 * (qb + 1); a.j_lo = (a.P0 - 511) > 0 ? ((a.P0 - 511) >> 6) : 0;
                    a.Q = zb + (size_t)a.P0 * LDZ0 + ZQ + hq * HD; a.K = zb + ZKV + (8 + g2) * HD; a.V = zb + ZKV + (10 + g2) * HD;
                    a.O = OW + (size_t)(b * T + a.P0) * 1024 + hq * HD;
                    att::attn_block<att::M_WIN>((char*)lds, a, tq); } }
        }
        SEAM(5);
        if (IN(6)) { PHASE_LOCALS;
            const float* lamp = KIN(I_DIFFLAM); const float* subg = KIN(I_DIFFSUB);
            const float s1 = wave_sum(lamp[lane] * lamp[HD + lane] + lamp[64 + lane] * lamp[HD + 64 + lane]);
            const float s2 = wave_sum(lamp[2 * HD + lane] * lamp[3 * HD + lane] + lamp[2 * HD + 64 + lane] * lamp[3 * HD + 64 + lane]);
            const float lam_init = 0.2f, lam = __expf(s1) - __expf(s2) + lam_init;
            for (int m = gw; m < NTOK; m += NGW) { const size_t ro = (size_t)m * 1024; bf16_t* om = OMIX + (size_t)m * DM;
                for (int hq = 0; hq < 8; ++hq) { const float gc = GATES[(size_t)m * 24 + hq * 3], gs = GATES[(size_t)m * 24 + hq * 3 + 1], gwn = GATES[(size_t)m * 24 + hq * 3 + 2];
                    const unsigned c = *(const unsigned*)(OC + ro + hq * HD + 2 * lane), s = *(const unsigned*)(OS + ro + hq * HD + 2 * lane), w = *(const unsigned*)(OW + ro + hq * HD + 2 * lane);
                    const float v0 = gc * bf2f((unsigned short)c) + gs * bf2f((unsigned short)s) + gwn * bf2f((unsigned short)w);
                    const float v1 = gc * bf2f((unsigned short)(c >> 16)) + gs * bf2f((unsigned short)(s >> 16)) + gwn * bf2f((unsigned short)(w >> 16));
                    *(unsigned*)(om + hq * HD + 2 * lane) = pk2(v0, v1); }
                for (int h = 0; h < 4; ++h) { const u32x2 a1 = *(const u32x2*)(O1 + ro + h * 256 + 4 * lane), a2 = *(const u32x2*)(O2 + ro + h * 256 + 4 * lane);
                    float v[4]; v[0] = bf2f((unsigned short)a1.x) - lam * bf2f((unsigned short)a2.x); v[1] = bf2f((unsigned short)(a1.x >> 16)) - lam * bf2f((unsigned short)(a2.x >> 16));
                    v[2] = bf2f((unsigned short)a1.y) - lam * bf2f((unsigned short)a2.y); v[3] = bf2f((unsigned short)(a1.y >> 16)) - lam * bf2f((unsigned short)(a2.y >> 16));
                    const float rstd = rsqrtf(wave_sum((v[0] * v[0] + v[1] * v[1]) + (v[2] * v[2] + v[3] * v[3])) * (1.f / 256.f) + EPS) * (1.f - lam_init);
                    const f32x4 sg = *(const f32x4*)(subg + 4 * lane);
                    u32x2 w; w.x = pk2(v[0] * rstd * sg.x, v[1] * rstd * sg.y); w.y = pk2(v[2] * rstd * sg.z, v[3] * rstd * sg.w);
                    *(u32x2*)(om + 1024 + h * 256 + 4 * lane) = w; } }
        }
        SEAM(6);
        if (IN(7)) { PHASE_LOCALS; pg8::Dims g{DM, DM * 2, DM * 2, 0}; pg8::DenseOrder S; S.init(OMIX, W_EVOUT, NTOK, DM, DM * 2, DM * 2, G, bx); pg8::EpiF32 E{xs, x_in, DM};
            pg8::gemm_phase<pg8::EpiF32, pg8::DenseOrder>(ldsl, g, S, E, tid); }
        SEAM(7);
      } else {
        if (IN(19)) { PHASE_LOCALS; pg8::Dims g{DM, DM * 2, DM * 2, 0}; pg8::DenseOrder S; S.init(HB, W_ODIN, NTOK, LDZ1, DM * 2, DM * 2, G, bx); pg8::EpiBf16 E{Z, LDZ1};
            pg8::gemm_phase<pg8::EpiBf16, pg8::DenseOrder>(ldsl, g, S, E, tid); }
        SEAM(19);
        if (IN(20)) { PHASE_LOCALS;
            const float* fg = KIN(I_FOXG);
            for (int m = gw; m < NTOK; m += NGW) { bf16_t* zr = Z + (size_t)m * LDZ1;
                for (int h = 0; h < 16; ++h) { head_norm<false>(zr + Z1Q + h * HD, fg, nullptr, lane); head_norm<false>(zr + Z1K + h * HD, fg + HD, nullptr, lane); } }
            for (int s = gw; s < 64; s += NGW) { const int b = s >> 4, h = s & 15; const float fb = KIN(I_FOXB)[h];
                const bf16_t* zc = Z + (size_t)(b * T + 64 * lane) * LDZ1 + Z1F + h; float run = 0.f;
                for (int i = 0; i < 64; ++i) { const float v = bf2f(zc[(size_t)i * LDZ1]) + fb; run += fminf(v, 0.f) - log1pf(__expf(-fabsf(v))); }
                float incl = run;
#pragma unroll
                for (int o = 1; o < 64; o <<= 1) { const float tv = __shfl_up(incl, o); if (lane >= o) incl += tv; }
                float base = incl - run; float* cbp = CBUF + (size_t)s * T + 64 * lane;
                for (int i = 0; i < 64; ++i) { const float v = bf2f(zc[(size_t)i * LDZ1]) + fb; base += fminf(v, 0.f) - log1pf(__expf(-fabsf(v))); cbp[i] = base; } }
        }
        SEAM(20);
        if (IN(21)) { PHASE_LOCALS; const int tq = tid;
            for (int i = 0;; ++i) { const int idx = deal(i, G, bx); if (idx >= 1024) break;
                const int qb = 15 - (idx >> 6), r = idx & 63, b = r >> 4, h = r & 15; const bf16_t* zb = Z + (size_t)(b * T) * LDZ1;
                att::AttnArgs a; a.ldq = LDZ1; a.ldk = LDZ1; a.ldv = LDZ1; a.ldo = DM; a.P0 = qb * 256; a.j_lo = 0; a.j_hi = 4 * (qb + 1); a.sel = nullptr; a.qg = nullptr;
                a.Q = zb + (size_t)a.P0 * LDZ1 + Z1Q + h * HD; a.K = zb + Z1K + h * HD; a.V = zb + Z1V + h * HD; a.O = OMIX + (size_t)(b * T + a.P0) * DM + h * HD; a.cb = CBUF + (size_t)(b * 16 + h) * T;
                att::attn_block<att::M_FOX>((char*)lds, a, tq); }
        }
        SEAM(21);
        if (IN(22)) { PHASE_LOCALS; pg8::Dims g{DM, DM * 2, DM * 2, 0}; pg8::DenseOrder S; S.init(OMIX, W_ODOUT, NTOK, DM, DM * 2, DM * 2, G, bx); pg8::EpiF32 E{xs, xs, DM};
            pg8::gemm_phase<pg8::EpiF32, pg8::DenseOrder>(ldsl, g, S, E, tid); }
        SEAM(22);
      }
      const int cb = l ? 23 : 8;
      if (INC(0)) { PHASE_LOCALS; for (int m = gw; m < NTOK; m += NGW) norm_row(xs + (size_t)m * DM, normg + (size_t)(l * 4 + 1) * DM, HB + (size_t)m * DM, lane); }
      SEAM(cb + 0);
      if (INC(1)) { PHASE_LOCALS; pg8::Dims g{DM, DM * 2, DM * 2, 0}; pg8::DenseOrder S; S.init(HB, W_CAQ + (size_t)l * 512 * DM, NTOK, 512, DM * 2, DM * 2, G, bx); pg8::EpiBf16 E{CAQ, 512};
          pg8::gemm_phase<pg8::EpiBf16, pg8::DenseOrder>(ldsl, g, S, E, tid); }
      SEAM(cb + 1);
      if (INC(2)) { PHASE_LOCALS; const int tq = tid;
          for (int i = 0;; ++i) { const int idx = i * G + bx; if (idx >= 256) break;
              const int b = idx >> 6, h = (idx >> 4) & 3, qb = idx & 15; const bf16_t* kvb = CAKV + (size_t)l * 1024 * 1024 + (size_t)b * 256 * 1024;
              att::AttnArgs a; a.ldq = 512; a.ldk = 1024; a.ldv = 1024; a.ldo = 512; a.P0 = qb * 256; a.j_lo = 0; a.j_hi = 4; a.cb = nullptr; a.sel = nullptr; a.qg = KIN(I_CAG) + (l * 2) * HD;
              a.Q = CAQ + (size_t)(b * T + a.P0) * 512 + h * HD; a.K = kvb + h * HD; a.V = kvb + 512 + h * HD; a.O = OCA + (size_t)(b * T + a.P0) * 512 + h * HD;
              att::attn_block<att::M_NONE>((char*)lds, a, tq); }
      }
      SEAM(cb + 2);
      if (INC(3)) { PHASE_LOCALS; pg8::Dims g{512, 512 * 2, 512 * 2, 0}; pg8::DenseOrder S; S.init(OCA, W_CAO + (size_t)l * DM * 512, NTOK, DM, 512 * 2, 512 * 2, G, bx); pg8::EpiF32 E{xs, xs, DM};
          pg8::gemm_phase<pg8::EpiF32, pg8::DenseOrder>(ldsl, g, S, E, tid); }
      SEAM(cb + 3);
      if (INC(4)) { PHASE_LOCALS; for (int m = gw; m < NTOK; m += NGW) norm_row(xs + (size_t)m * DM, normg + (size_t)(l * 4 + 3) * DM, HB + (size_t)m * DM, lane); }
      SEAM(cb + 4);
      if (INC(5)) { PHASE_LOCALS; pg8::Dims g{DM, DM * 2, DM * 2, 0}; pg8::DenseOrder S; S.init(HB, W_RT + (size_t)l * 256 * DM, NTOK, 256, DM * 2, DM * 2, G, bx); pg8::EpiF32 E{LOGITS, nullptr, 256};
          pg8::gemm_phase<pg8::EpiF32, pg8::DenseOrder>(ldsl, g, S, E, tid); }
      SEAM(cb + 5);
      if (INC(6)) { PHASE_LOCALS;
          const float* bg = KIN(I_MOEBG) + l * 4; const float* be = KIN(I_MOEBE) + l * 32; unsigned* cnt = ctl + CW_CNT + 64 * l;
          LAS int* flist = (LAS int*)ldsl; LAS int* fcnt = (LAS int*)(ldsl + 4096);
          if (tid == 0) *fcnt = 0;
          __syncthreads();
          for (int m0 = bx * 64; m0 < NTOK; m0 += G * 64) { if (tid < 64) { const int m = m0 + tid;
              const RouteDec d = route_decide(LOGITS + (size_t)m * 256, bg, be);
              if (d.margin < ROUTE_TAU) { const int ix = __hip_atomic_fetch_add(fcnt, 1, __ATOMIC_RELAXED, __HIP_MEMORY_SCOPE_WORKGROUP); flist[ix] = m; }
              else route_commit(m, d.grp, d.j0, d.j1, d.w0, d.w1, cnt, R_EID, R_WT, R_RANK); } }
          __syncthreads();
          const int nf = *fcnt; const float* we = KIN(I_MOEWE) + (size_t)l * DM * 32; const float* wg = KIN(I_MOEWG) + (size_t)l * DM * 4; const float* gn = normg + (size_t)(l * 4 + 3) * DM;
          for (int fi = wave; fi < nf; fi += 8) { const int m = flist[fi];
              const f32x4* xr = (const f32x4*)(xs + (size_t)m * DM) + lane; const f32x4* gr = (const f32x4*)gn + lane;
              f32x4 h[8]; float ss = 0.f;
#pragma unroll
              for (int j = 0; j < 8; ++j) { h[j] = xr[64 * j]; ss += (h[j].x * h[j].x + h[j].y * h[j].y) + (h[j].z * h[j].z + h[j].w * h[j].w); }
              const float rstd = rsqrtf(wave_sum(ss) * (1.f / DM) + EPS);
              f32x4 acc[9];
#pragma unroll
              for (int q = 0; q < 9; ++q) acc[q] = (f32x4){0.f, 0.f, 0.f, 0.f};
#pragma unroll
              for (int j = 0; j < 8; ++j) { const f32x4 gg = gr[64 * j]; const f32x4 hv = h[j] * gg * rstd;
#pragma unroll
                  for (int i = 0; i < 4; ++i) { const int k = 4 * (lane + 64 * j) + i; const float hk = hv[i]; const f32x4* wr_ = (const f32x4*)(we + (size_t)k * 32);
#pragma unroll
                      for (int q = 0; q < 8; ++q) acc[q] += wr_[q] * hk;
                      acc[8] += *(const f32x4*)(wg + (size_t)k * 4) * hk; } }
              float mine = 0.f;
#pragma unroll
              for (int q = 0; q < 9; ++q)
#pragma unroll
                  for (int i = 0; i < 4; ++i) { const float sv = wave_sum(acc[q][i]); if (lane == 4 * q + i) mine = sv; }
              float* lgw = LOGITS + (size_t)m * 256;
              if (lane < 36) lgw[lane] = mine;
              VM_WAIT(); asm volatile("" ::: "memory");
              if (lane == 0) { const RouteDec d = route_decide(lgw, bg, be); route_commit(m, d.grp, d.j0, d.j1, d.w0, d.w1, cnt, R_EID, R_WT, R_RANK); } }
          __syncthreads();
      }
      SEAM(cb + 6);
      if (INC(7) || INC(8) || INC(9)) { PHASE_LOCALS;
          if (tid == 0) { const unsigned* cnt = ctl + CW_CNT + 64 * l; int acc = 0; for (int e = 0; e < NEXP; ++e) { tstart[e] = acc; acc += (int)((__hip_atomic_load(cnt + e, __ATOMIC_RELAXED, __HIP_MEMORY_SCOPE_AGENT) + 255u) >> 8); } tstart[NEXP] = acc; }
          __syncthreads();
      }
      if (INC(7)) { PHASE_LOCALS;
          for (int s = gw; s < 2 * NTOK; s += NGW) { const int e = R_EID[s], dest = tstart[e] * 256 + R_RANK[s]; if (lane == 0) R_SLOT[s] = dest;
              const u32x4* src = (const u32x4*)(HB + (size_t)(s >> 1) * DM) + lane; u32x4* dst = (u32x4*)(XS + (size_t)dest * DM) + lane;
#pragma unroll
              for (int j = 0; j < 4; ++j) dst[64 * j] = src[64 * j]; }
      }
      SEAM(cb + 7);
      if (INC(8)) { PHASE_LOCALS; pg8::Dims g{DM, DM * 2, DM * 2, 0}; MoeOrder S{(const char*)XS, (size_t)256 * DM * 2, (const char*)W_M13, (size_t)1024 * DM * 2, (size_t)256 * DM * 2, 4, tstart[NEXP] * 4, G, bx, tstart};
          pg8::EpiSwiglu E{HM}; pg8::gemm_phase<pg8::EpiSwiglu, MoeOrder>(ldsl, g, S, E, tid); }
      SEAM(cb + 8);
      if (INC(9)) { PHASE_LOCALS; pg8::Dims g{FF, FF * 2, FF * 2, 0}; MoeOrder S{(const char*)HM, (size_t)256 * FF * 2, (const char*)W_M2, (size_t)DM * FF * 2, (size_t)256 * FF * 2, 8, tstart[NEXP] * 8, G, bx, tstart};
          pg8::EpiBf16 E{YB, DM}; pg8::gemm_phase<pg8::EpiBf16, MoeOrder>(ldsl, g, S, E, tid); }
      SEAM(cb + 9);
      if (INC(10)) { PHASE_LOCALS;
          for (int m = gw; m < NTOK; m += NGW) { const float w0 = R_WT[2 * m], w1 = R_WT[2 * m + 1]; const u32x2* y0 = (const u32x2*)(YB + (size_t)R_SLOT[2 * m] * DM) + lane; const u32x2* y1 = (const u32x2*)(YB + (size_t)R_SLOT[2 * m + 1] * DM) + lane;
              f32x4* xr = (f32x4*)(xs + (size_t)m * DM) + lane; f32x4 v[8]; float ss = 0.f;
#pragma unroll
              for (int j = 0; j < 8; ++j) { const u32x2 a = y0[64 * j], b = y1[64 * j]; f32x4 x = xr[64 * j];
                  x.x += w0 * bf2f((unsigned short)a.x) + w1 * bf2f((unsigned short)b.x); x.y += w0 * bf2f((unsigned short)(a.x >> 16)) + w1 * bf2f((unsigned short)(b.x >> 16));
                  x.z += w0 * bf2f((unsigned short)a.y) + w1 * bf2f((unsigned short)b.y); x.w += w0 * bf2f((unsigned short)(a.y >> 16)) + w1 * bf2f((unsigned short)(b.y >> 16));
                  xr[64 * j] = x; v[j] = x; ss += (x.x * x.x + x.y * x.y) + (x.z * x.z + x.w * x.w); }
              if (l == 0) { const float rstd = rsqrtf(wave_sum(ss) * (1.f / DM) + EPS); const f32x4* gr = (const f32x4*)(normg + (size_t)4 * DM) + lane; u32x2* o8 = (u32x2*)(HB + (size_t)m * DM) + lane;
#pragma unroll
                  for (int j = 0; j < 8; ++j) { const f32x4 gg = gr[64 * j]; u32x2 w; w.x = pk2(v[j].x * rstd * gg.x, v[j].y * rstd * gg.y); w.y = pk2(v[j].z * rstd * gg.z, v[j].w * rstd * gg.w); o8[64 * j] = w; } } }
          if (l == 0) moe_convert(KIN(I_MOEW1) + (size_t)NEXP * DM * FF, KIN(I_MOEW3) + (size_t)NEXP * DM * FF, KIN(I_MOEW2) + (size_t)NEXP * FF * DM, W_M13, W_M2, scr, gw, NGW, lane);
      }
      if (l == 0) SEAM(cb + 10);
    }
#undef IN
#undef INC
#undef SEAM
}

extern "C" void kernel_launch(void* const* d_in, const int* in_sizes, int n_in, void* d_out, int out_size, void* d_ws, size_t ws_size, hipStream_t stream) {
    static int grid = 0;
    if (grid == 0) {
        if (n_in != 27 || out_size != NTOK * DM || ws_size < WS_END) { fprintf(stderr, "kernel_launch: unexpected shapes (n_in %d out %d ws %zu)\n", n_in, out_size, ws_size); grid = -1; return; }
        int dev = 0, cus = 0, per_cu = 0;
        if (hipGetDevice(&dev) != hipSuccess || hipDeviceGetAttribute(&cus, hipDeviceAttributeMultiprocessorCount, dev) != hipSuccess) { grid = -1; return; }
        if (hipFuncSetAttribute((const void*)mk_fwd, hipFuncAttributeMaxDynamicSharedMemorySize, LDS_BYTES) != hipSuccess) { grid = -1; return; }
        if (hipOccupancyMaxActiveBlocksPerMultiprocessor(&per_cu, (const void*)mk_fwd, 512, LDS_BYTES) != hipSuccess || per_cu < 1) fprintf(stderr, "kernel_launch: occupancy query says %d\n", per_cu);
        (void)hipGetLastError();
        grid = cus;
    }
    if (grid < 0) return;
    (void)hipMemsetAsync((char*)d_ws + WS_CTL, 0, CTL_ZERO_BYTES, stream);
    Args a{};
    for (int i = 0; i < 27; ++i) a.in[i] = (const float*)d_in[i];
    a.out = (float*)d_out; a.ws = (unsigned char*)d_ws;
#ifndef MK_CUTS
    a.ph_lo = 0; a.ph_hi = NPHASE;
    hipLaunchKernelGGL(mk_fwd, dim3(grid), dim3(512), LDS_BYTES, stream, a);
#else
    for (int p = 0; p < NPHASE; ++p) { a.ph_lo = p; a.ph_hi = p + 1; hipLaunchKernelGGL(mk_fwd, dim3(grid), dim3(512), LDS_BYTES, stream, a); }
#endif
}
```

```cpp
#include <hip/hip_runtime.h>
#include <cstdio>
#include <cstdint>

#define LAS __attribute__((address_space(3)))
#define GAS __attribute__((address_space(1)))
typedef unsigned short bf16_t;
typedef short bf16x8 __attribute__((ext_vector_type(8)));
typedef short s16x4 __attribute__((ext_vector_type(4)));
typedef float f32x2 __attribute__((ext_vector_type(2)));
typedef float f32x4 __attribute__((ext_vector_type(4)));
typedef float f32x16 __attribute__((ext_vector_type(16)));
typedef unsigned u32x2 __attribute__((ext_vector_type(2)));
typedef unsigned u32x4 __attribute__((ext_vector_type(4)));
typedef unsigned long long u64;

#define LDS_WAIT() asm volatile("s_waitcnt lgkmcnt(0)" ::: "memory")
#define VM_WAIT() asm volatile("s_waitcnt vmcnt(0)" ::: "memory")

constexpr int NB = 4, T = 4096, NTOK = NB * T, DM = 2048, HD = 128;
constexpr float EPS = 1e-6f;
constexpr int LDZ0 = 5888, LDZ1 = 6400;
constexpr int ZQ = 0, ZKV = 1024, ZDQ = 2560, ZDK = 3584, ZDV = 4608, ZG = 5632;
constexpr int Z1Q = 0, Z1K = 2048, Z1V = 4096, Z1F = 6144;
constexpr int NEXP = 32, FF = 512, PMAX = 40960;

constexpr size_t MiB = 1u << 20;
constexpr size_t WS_CTL = 0, CTL_ZERO_BYTES = 1 * MiB;
constexpr size_t WS_ROPE = 1 * MiB, WS_MISC = 3 * MiB, WS_GATES = 4 * MiB, WS_SEL = 6 * MiB, WS_CBUF = 7 * MiB, WS_ROUTE = 8 * MiB;
constexpr size_t WS_KC = 9 * MiB, WS_VC = 9 * MiB + 512 * 1024, WS_HID = 10 * MiB, WS_CAKV = 12 * MiB, WS_MEMN = 16 * MiB;
constexpr size_t WS_W_EVIN = 24 * MiB, WS_W_EVOUT = 47 * MiB, WS_W_CMP1 = 55 * MiB, WS_W_ODIN = 59 * MiB, WS_W_ODOUT = 84 * MiB;
constexpr size_t WS_W_CAQ = 92 * MiB, WS_W_CAKV = 96 * MiB, WS_W_CAO = 104 * MiB, WS_W_RT = 108 * MiB, WS_W_M13 = 110 * MiB, WS_W_M2 = 238 * MiB;
constexpr size_t WS_HB = 302 * MiB, WS_Z = 366 * MiB, WS_XS = WS_Z, WS_ATT = 567 * MiB, WS_YB = WS_ATT;
constexpr size_t WS_OC = WS_ATT, WS_OS = WS_ATT + 32 * MiB, WS_OW = WS_ATT + 64 * MiB, WS_O1 = WS_ATT + 96 * MiB, WS_O2 = WS_ATT + 128 * MiB, WS_OMIX = WS_ATT + 160 * MiB;
constexpr size_t WS_CAQ = 791 * MiB, WS_OCA = 807 * MiB, WS_LOGITS = 823 * MiB, WS_HM = 839 * MiB, WS_END = 879 * MiB;
static_assert((size_t)(NTOK + 32) * LDZ1 * 2 <= 201 * MiB && (size_t)PMAX * DM * 2 <= 201 * MiB, "z / xs region");
constexpr int CW_ERR = 0, CW_BAR = 4096, CW_CNT = 8192;

constexpr int RING_BYTES = 131072, MISC_OFF = RING_BYTES, MOE_OFF = RING_BYTES + 512, LDS_BYTES = 147456;

__device__ __forceinline__ unsigned f2bf(float f) { unsigned u = __builtin_bit_cast(unsigned, f); return (u + 0x7fffu + ((u >> 16) & 1u)) >> 16; }
__device__ __forceinline__ unsigned pk2(float lo, float hi) { return f2bf(lo) | (f2bf(hi) << 16); }
__device__ __forceinline__ float bf2f(unsigned short b) { return __builtin_bit_cast(float, (unsigned)b << 16); }
__device__ __forceinline__ unsigned cvtpk(float lo, float hi) { unsigned r; asm volatile("v_cvt_pk_bf16_f32 %0, %1, %2" : "=v"(r) : "v"(lo), "v"(hi)); return r; }
__device__ __forceinline__ int opaque(int v) { asm volatile("" : "+v"(v)); return v; }
__device__ __forceinline__ float wave_sum(float v) {
#pragma unroll
    for (int o = 1; o < 64; o <<= 1) v += __shfl_xor(v, o);
    return v;
}

#define XB_TMO      128
#define XB_XCNT(j)  (256  + 64 * (j))
#define XB_XSUB(j)  (1280 + 64 * (j))
#define XB_XGEN(j)  (2304 + 64 * (j))
#define XB_TOP      3328
#define XB_TOPGEN   3392
#define XCD_BAR_WORDS 3456
#define XB_SPIN_CAP (1u << 18)
__device__ __forceinline__ unsigned xb_ld(unsigned* p)              { return __hip_atomic_load(p, __ATOMIC_RELAXED, __HIP_MEMORY_SCOPE_AGENT); }
__device__ __forceinline__ unsigned xb_add(unsigned* p, unsigned v) { return __hip_atomic_fetch_add(p, v, __ATOMIC_RELAXED, __HIP_MEMORY_SCOPE_AGENT); }
__device__ __forceinline__ unsigned xb_xcc_id() { return (unsigned)__builtin_amdgcn_s_getreg((3 << 11) | 20) & 0xFu; }
#define XB_SPIN(cond, bar) do { unsigned _sp = 0; while (cond) { __builtin_amdgcn_s_sleep(1); \
    if ((++_sp & 255u) == 0u) { if (xb_ld(&(bar)[XB_TMO])) break; if (_sp > XB_SPIN_CAP) { atomicAdd(&(bar)[XB_TMO], 1u); break; } } } } while (0)
struct XcdBarrier { unsigned* bar; unsigned x; volatile LAS unsigned* st; };
__device__ __forceinline__ XcdBarrier xcd_barrier_post(unsigned* bar, volatile LAS unsigned* st) {
    XcdBarrier b; b.bar = bar; b.x = xb_xcc_id(); b.st = st;
    if (threadIdx.x == 0) (void)xb_add(&bar[XB_XCNT(b.x)], 1u);
    return b;
}
__device__ __forceinline__ void xcd_barrier_complete(unsigned* bar, unsigned x, unsigned& nloc, unsigned& nx) {
    const unsigned G = gridDim.x * gridDim.y * gridDim.z;
    unsigned sum, cnt, mine, sp = 0u;
    for (;;) {
        sum = 0u; cnt = 0u; mine = 0u;
#pragma unroll
        for (unsigned j = 0; j < 16; ++j) { const unsigned c = xb_ld(&bar[XB_XCNT(j)]); sum += c; cnt += (c > 0u) ? 1u : 0u; mine = (j == x) ? c : mine; }
        if (sum == G) break;
        __builtin_amdgcn_s_sleep(1);
        if ((++sp & 255u) == 0u) { if (xb_ld(&bar[XB_TMO])) break; if (sp > XB_SPIN_CAP) { atomicAdd(&bar[XB_TMO], 1u); break; } }
    }
    nloc = mine > 0u ? mine : 1u; nx = cnt > 0u ? cnt : 1u;
}
__device__ __forceinline__ void xcd_barrier(const XcdBarrier& b) {
    asm volatile("s_waitcnt vmcnt(0)" ::: "memory");
    __syncthreads();
    if (threadIdx.x == 0) {
        unsigned* bar = b.bar;
        __builtin_amdgcn_s_waitcnt(0);
        unsigned nloc = b.st[0], nx = b.st[1];
        if (nloc == 0u) { xcd_barrier_complete(bar, b.x, nloc, nx); b.st[0] = nloc; b.st[1] = nx; }
        const unsigned old = xb_add(&bar[XB_XSUB(b.x)], 1u);
        const unsigned gen = old / nloc;
        if (old + 1u == (gen + 1u) * nloc) {
            __builtin_amdgcn_fence(__ATOMIC_RELEASE, "agent");
            asm volatile("s_waitcnt vmcnt(0)" ::: "memory");
            const unsigned og = xb_add(&bar[XB_TOP], 1u);
            const unsigned tg = og / nx;
            if (og + 1u == (tg + 1u) * nx) xb_add(&bar[XB_TOPGEN], 1u);
            else XB_SPIN(xb_ld(&bar[XB_TOPGEN]) == tg, bar);
            __builtin_amdgcn_fence(__ATOMIC_ACQUIRE, "agent");
            xb_add(&bar[XB_XGEN(b.x)], 1u);
            asm volatile("s_waitcnt vmcnt(0)" ::: "memory");
        } else {
            XB_SPIN(xb_ld(&bar[XB_XGEN(b.x)]) == gen, bar);
            __builtin_amdgcn_fence(__ATOMIC_ACQUIRE, "agent");
            asm volatile("s_waitcnt vmcnt(0)" ::: "memory");
        }
    }
    __syncthreads();
}

namespace pg8 {
constexpr int BM = 256, BK = 64, HALF = 128, HTB = HALF * BK * 2, STAGE_BYTES = 8 * HTB, NXCD = 8, WGM = 8;
__host__ __device__ __forceinline__ int lds_byte(int r, int c) { const int st = (r >> 4) * 2 + (c >> 5), rr = r & 15, cc = c & 31, ob = rr * 64 + cc * 2; return st * 1024 + (ob ^ (((ob >> 9) & 1) << 5)); }
__host__ __device__ __forceinline__ void stage_rc(int b, int& R, int& C) { const int st = b / 1024, sb = b % 1024, swz = sb ^ (((sb >> 9) & 1) << 5); R = (st >> 1) * 16 + swz / 64; C = (st & 1) * 32 + (swz % 64) / 2; }
__host__ __device__ __forceinline__ int perm32(int rho) { const int n = rho >> 4, i = rho & 15; return 8 * (i >> 2) + 4 * n + (i & 3); }

struct Unit { const char* a; const char* b; int pm, pn; };
struct Dims { int K; int lda, ldb; int segstride; };

struct DenseOrder {
    const char* A; const char* Bt; size_t tA, tB;
    int nM, nN, nwg, G, c;
    __device__ void init(const void* A_, const void* Bt_, int M, int N, size_t lda, size_t ldb, int G_, int c_) { A = (const char*)A_; Bt = (const char*)Bt_; tA = 256 * lda; tB = 256 * ldb; nM = M / BM; nN = N / BM; nwg = nM * nN; G = G_; c = c_; }
    __device__ bool next(int i, Unit& u) const {
        const long L = (long)i * G + c; if (L >= nwg) return false;
        int wgid = (int)L; { const int q = nwg / NXCD, r = nwg % NXCD, xcd = wgid % NXCD, off = wgid / NXCD; wgid = (xcd < r ? xcd * (q + 1) : r * (q + 1) + (xcd - r) * q) + off; }
        const int nig = WGM * nN, gid = wgid / nig, fm = gid * WGM, gsz = (nM - fm) < WGM ? (nM - fm) : WGM;
        u.pm = fm + ((wgid % nig) % gsz); u.pn = (wgid % nig) / gsz; u.a = A + (size_t)u.pm * tA; u.b = Bt + (size_t)u.pn * tB; return true;
    }
};

template <class Epi, class Sched, bool SEG = false>
__device__ __forceinline__ void gemm_phase(LAS unsigned char* lds, const Dims g, const Sched& S, const Epi& E, const int tid) {
    const int wid = __builtin_amdgcn_readfirstlane(tid >> 6), lane = tid & 63, wr = wid >> 2, wc = wid & 3, fr = lane & 15, fq = lane >> 4;
    const int K = g.K, nt = K / BK;
    unsigned voffA[2], voffB[2];
#pragma unroll
    for (int i = 0; i < 2; ++i) { int R, C; stage_rc(tid * 16 + i * 8192, R, C); const int Rb = Epi::PERM ? ((R & ~31) + perm32(R & 31)) : R;
        voffA[i] = (unsigned)(R * g.lda + C * 2); voffB[i] = (unsigned)(Rb * g.ldb + C * 2); }
    const size_t hstepA = (size_t)HALF * g.lda, hstepB = (size_t)HALF * g.ldb;
    const unsigned ldsw = (unsigned)wid * 1024u;
    const int aoff = lds_byte(wr * 64 + fr, fq * 8), boff = lds_byte(wc * 32 + fr, fq * 8);
#define PG8_KOA(kt) (SEG ? ((size_t)((kt) >> 1) * (size_t)g.segstride + (size_t)((kt) & 1) * 128u) : (size_t)(kt) * 128u)
#define PG8_KOB(kt) ((size_t)(kt) * 128u)
#define PG8_SA(b, h) (((b) * 2 + (h)) * HTB)
#define PG8_SB(b, h) ((4 + (b) * 2 + (h)) * HTB)
#define PG8_STAGE(bufoff, gbase, voff) do { _Pragma("unroll") for (int _i = 0; _i < 2; ++_i) \
        __builtin_amdgcn_global_load_lds((const unsigned*)((const char*)(gbase) + (voff)[_i]), (LAS unsigned*)(lds + (bufoff) + ldsw + _i * 8192), 16, 0, 0); } while (0)
#define PG8_LDA(dst, b, h) do { _Pragma("unroll") for (int m = 0; m < 4; ++m) _Pragma("unroll") for (int k = 0; k < 2; ++k) dst[m][k] = *(const LAS bf16x8*)(lds + PG8_SA(b, h) + aoff + m * 2048 + k * 1024); } while (0)
#define PG8_LDB(dst, b, h) do { _Pragma("unroll") for (int n = 0; n < 2; ++n) _Pragma("unroll") for (int k = 0; k < 2; ++k) dst[n][k] = *(const LAS bf16x8*)(lds + PG8_SB(b, h) + boff + n * 2048 + k * 1024); } while (0)
#define PG8_MMA(ai, bj, At, Bt) do { __builtin_amdgcn_s_setprio(1); _Pragma("unroll") for (int m = 0; m < 4; ++m) _Pragma("unroll") for (int n = 0; n < 2; ++n) _Pragma("unroll") for (int k = 0; k < 2; ++k) \
        acc[ai][bj][m][n] = __builtin_amdgcn_mfma_f32_16x16x32_bf16(Bt[n][k], At[m][k], acc[ai][bj][m][n], 0, 0, 0); __builtin_amdgcn_s_setprio(0); } while (0)
#define PG8_WAIT_V(n) asm volatile("s_waitcnt vmcnt(" #n ")" ::: "memory")
#define PG8_WAIT_L(n) asm volatile("s_waitcnt lgkmcnt(" #n ")" ::: "memory")
#define PG8_BAR __builtin_amdgcn_s_barrier()
#define PG8_SCHED __builtin_amdgcn_sched_barrier(0)
    Unit cur, nxt; int ui = 0;
    if (!S.next(0, cur)) return;
    f32x4 acc[2][2][4][2];
#pragma unroll
    for (int a = 0; a < 2; ++a)
#pragma unroll
        for (int b = 0; b < 2; ++b)
#pragma unroll
            for (int m = 0; m < 4; ++m)
#pragma unroll
                for (int n = 0; n < 2; ++n) acc[a][b][m][n] = (f32x4){0.f, 0.f, 0.f, 0.f};
    bf16x8 At[4][2], B0[2][2], B1[2][2];
    const char* cA = cur.a; const char* cB = cur.b;
    PG8_STAGE(PG8_SB(0, 0), cB, voffB); PG8_STAGE(PG8_SB(0, 1), cB + hstepB, voffB); PG8_STAGE(PG8_SA(0, 0), cA, voffA); PG8_STAGE(PG8_SA(0, 1), cA + hstepA, voffA);
    if (wr == 1) PG8_BAR;
    PG8_WAIT_V(2); PG8_BAR;
    PG8_STAGE(PG8_SB(1, 0), cB + PG8_KOB(1), voffB); PG8_STAGE(PG8_SA(1, 0), cA + PG8_KOA(1), voffA); PG8_STAGE(PG8_SB(1, 1), cB + hstepB + PG8_KOB(1), voffB);
    PG8_WAIT_V(6); PG8_BAR;
    for (;;) {
        const bool has_next = S.next(ui + 1, nxt);
        const char* nA = has_next ? nxt.a : cA; const char* nB = has_next ? nxt.b : cB;
        for (int t = 0; t < nt; t += 2) {
            const bool last = (t == nt - 2);
            const char* a1 = cA + PG8_KOA(t + 1);
            const char* bA2 = last ? nA : cA; const char* bB2 = last ? nB : cB; const int kt2 = last ? 0 : t + 2;
            const char* a2 = bA2 + PG8_KOA(kt2); const char* b2 = bB2 + PG8_KOB(kt2);
            const char* a3 = bA2 + PG8_KOA(kt2 + 1); const char* b3 = bB2 + PG8_KOB(kt2 + 1);
            PG8_LDB(B0, 0, 0); PG8_LDB(B1, 0, 1); PG8_SCHED; PG8_LDA(At, 0, 0); PG8_STAGE(PG8_SA(1, 1), a1 + hstepA, voffA);
            PG8_WAIT_V(8); PG8_WAIT_L(0); PG8_BAR; PG8_MMA(0, 0, At, B0); PG8_MMA(0, 1, At, B1); PG8_BAR; PG8_SCHED;
            PG8_LDA(At, 0, 1); PG8_STAGE(PG8_SB(0, 0), b2, voffB); PG8_STAGE(PG8_SB(0, 1), b2 + hstepB, voffB); PG8_STAGE(PG8_SA(0, 0), a2, voffA);
            PG8_WAIT_V(8); PG8_WAIT_L(0); PG8_BAR; PG8_MMA(1, 0, At, B0); PG8_MMA(1, 1, At, B1); PG8_BAR; PG8_SCHED;
            PG8_LDB(B0, 1, 0); PG8_LDB(B1, 1, 1); PG8_SCHED; PG8_LDA(At, 1, 0); PG8_STAGE(PG8_SA(0, 1), a2 + hstepA, voffA);
            PG8_WAIT_V(8); PG8_WAIT_L(0); PG8_BAR; PG8_MMA(0, 0, At, B0); PG8_MMA(0, 1, At, B1); PG8_BAR; PG8_SCHED;
            PG8_LDA(At, 1, 1); PG8_STAGE(PG8_SB(1, 0), b3, voffB); PG8_STAGE(PG8_SB(1, 1), b3 + hstepB, voffB); PG8_STAGE(PG8_SA(1, 0), a3, voffA);
            PG8_WAIT_V(8); PG8_WAIT_L(0); PG8_BAR; PG8_MMA(1, 0, At, B0); PG8_MMA(1, 1, At, B1); PG8_BAR; PG8_SCHED;
        }
        if (wr == 0) PG8_BAR;
        E(acc, cur, wr, wc, fr, fq);
        if (!has_next) break;
#pragma unroll
        for (int a = 0; a < 2; ++a)
#pragma unroll
            for (int b = 0; b < 2; ++b)
#pragma unroll
                for (int m = 0; m < 4; ++m)
#pragma unroll
                    for (int n = 0; n < 2; ++n) acc[a][b][m][n] = (f32x4){0.f, 0.f, 0.f, 0.f};
        cur = nxt; cA = nA; cB = nB; ++ui;
        if (wr == 1) PG8_BAR;
    }
    PG8_WAIT_V(0);
    PG8_BAR;
#undef PG8_KOA
#undef PG8_KOB
#undef PG8_SA
#undef PG8_SB
#undef PG8_STAGE
#undef PG8_LDA
#undef PG8_LDB
#undef PG8_MMA
#undef PG8_WAIT_V
#undef PG8_WAIT_L
#undef PG8_BAR
#undef PG8_SCHED
}
}

namespace pg8 {
struct EpiBf16 {
    static constexpr bool PERM = true;
    bf16_t* O; int ldc;
    __device__ __forceinline__ void operator()(const f32x4 (&acc)[2][2][4][2], const Unit& u, int wr, int wc, int fr, int fq) const {
        const int row0 = u.pm * BM + wr * 64 + fr, col0 = u.pn * BM + wc * 32 + 8 * fq;
#pragma unroll
        for (int ai = 0; ai < 2; ++ai)
#pragma unroll
            for (int m = 0; m < 4; ++m) { bf16_t* rowp = O + (size_t)(row0 + ai * HALF + m * 16) * ldc + col0;
#pragma unroll
                for (int bj = 0; bj < 2; ++bj) { const f32x4 v0 = acc[ai][bj][m][0], v1 = acc[ai][bj][m][1];
                    u32x4 w; w.x = cvtpk(v0[0], v0[1]); w.y = cvtpk(v0[2], v0[3]); w.z = cvtpk(v1[0], v1[1]); w.w = cvtpk(v1[2], v1[3]);
                    *(u32x4*)(rowp + bj * HALF) = w; } }
    }
};
struct EpiF32 {
    static constexpr bool PERM = false;
    float* C; const float* R; int ldc;
    __device__ __forceinline__ void operator()(const f32x4 (&acc)[2][2][4][2], const Unit& u, int wr, int wc, int fr, int fq) const {
        const int row0 = u.pm * BM + wr * 64 + fr, col0 = u.pn * BM + wc * 32 + 4 * fq;
#pragma unroll
        for (int ai = 0; ai < 2; ++ai)
#pragma unroll
            for (int m = 0; m < 4; ++m) { const size_t ro = (size_t)(row0 + ai * HALF + m * 16) * ldc + col0;
#pragma unroll
                for (int bj = 0; bj < 2; ++bj)
#pragma unroll
                    for (int n = 0; n < 2; ++n) { f32x4 v = acc[ai][bj][m][n]; if (R) v += *(const f32x4*)(R + ro + bj * HALF + n * 16); *(f32x4*)(C + ro + bj * HALF + n * 16) = v; } }
    }
};
struct EpiGelu {
    static constexpr bool PERM = true;
    bf16_t* O; const float* bias;
    __device__ __forceinline__ void operator()(const f32x4 (&acc)[2][2][4][2], const Unit& u, int wr, int wc, int fr, int fq) const {
        const int row0 = u.pm * BM + wr * 64 + fr, col0 = wc * 32 + 8 * fq;
        bf16_t* Ob = O + (size_t)u.pn * 2048 * 256; const float* bb = bias + u.pn * 256;
#pragma unroll
        for (int ai = 0; ai < 2; ++ai)
#pragma unroll
            for (int m = 0; m < 4; ++m) { bf16_t* rowp = Ob + (size_t)(row0 + ai * HALF + m * 16) * 256 + col0;
#pragma unroll
                for (int bj = 0; bj < 2; ++bj) { float v[8];
#pragma unroll
                    for (int n = 0; n < 2; ++n) { const f32x4 bv = *(const f32x4*)(bb + col0 + bj * HALF + 4 * n);
#pragma unroll
                        for (int j = 0; j < 4; ++j) { const float x = acc[ai][bj][m][n][j] + bv[j]; const float uu = 1.5957691216f * (x + 0.044715f * x * x * x); v[4 * n + j] = x / (1.0f + __expf(-uu)); } }
                    u32x4 w; w.x = cvtpk(v[0], v[1]); w.y = cvtpk(v[2], v[3]); w.z = cvtpk(v[4], v[5]); w.w = cvtpk(v[6], v[7]);
                    *(u32x4*)(rowp + bj * HALF) = w; } }
    }
};
struct EpiSwiglu {
    static constexpr bool PERM = true;
    bf16_t* O;
    __device__ __forceinline__ void operator()(const f32x4 (&acc)[2][2][4][2], const Unit& u, int wr, int wc, int fr, int fq) const {
        const int row0 = u.pm * BM + wr * 64 + fr, col0 = u.pn * HALF + wc * 32 + 8 * fq;
#pragma unroll
        for (int ai = 0; ai < 2; ++ai)
#pragma unroll
            for (int m = 0; m < 4; ++m) { bf16_t* rowp = O + (size_t)(row0 + ai * HALF + m * 16) * FF + col0; float v[8];
#pragma unroll
                for (int n = 0; n < 2; ++n)
#pragma unroll
                    for (int j = 0; j < 4; ++j) { const float a = acc[ai][0][m][n][j], b = acc[ai][1][m][n][j]; v[4 * n + j] = a / (1.0f + __expf(-a)) * b; }
                u32x4 w; w.x = cvtpk(v[0], v[1]); w.y = cvtpk(v[2], v[3]); w.z = cvtpk(v[4], v[5]); w.w = cvtpk(v[6], v[7]);
                *(u32x4*)rowp = w; }
    }
};
}

namespace att {
constexpr float SCALE = 0.08838834764831845f, THR = 8.f;
constexpr int KVBLK = 64, SHM_V = 16384, SHM_K = 16384;
constexpr int ATT_SCR = 65536, ATT_CST = 65536 + 2048, ATT_IMP = 65536 + 4096;
#define KSWZ(row, colB) ((row) * 256 + ((colB) ^ (((row) & 7) << 4)))
#define SBAR() __builtin_amdgcn_sched_barrier(0)
__device__ __forceinline__ int v_st(int k, int c) { const int kk = (k & ~0xC) | ((k & 4) << 1) | ((k & 8) >> 1); return ((kk >> 3) * 4 + (c >> 5)) * 512 + ((kk & 7) * 32 + (c & 31)) * 2; }
__device__ __forceinline__ int v_rd_base(int lane) { return ((lane & 3) << 3) | (((lane >> 2) & 3) << 6) | (((lane >> 4) & 1) << 5) | (((lane >> 5) & 1) << 8); }
constexpr int v_rd_off(int d0, int ks, int half) { return d0 * 512 + ks * 4096 + half * 2048; }
__device__ __forceinline__ int crow(int r, int hi) { return (r & 3) + 8 * (r >> 2) + 4 * hi; }
__device__ __forceinline__ void mask_tile(f32x16& p0, f32x16& p1, int dq, unsigned W) {
    const float NEG = -__builtin_inff();
#pragma unroll
    for (int r = 0; r < 16; ++r) {
        const int c = (r & 3) + 8 * (r >> 2);
        if ((unsigned)(dq - c) >= W) p0[r] = NEG;
        if ((unsigned)(dq - c - 32) >= W) p1[r] = NEG;
    }
}
__device__ __forceinline__ void partialSM(f32x16& p0, f32x16& p1, float& m_reg, float& mn, float& alpha) {
    float pmax = p0[0];
#pragma unroll
    for (int r = 1; r < 16; ++r) pmax = fmaxf(pmax, p0[r]);
#pragma unroll
    for (int r = 0; r < 16; ++r) pmax = fmaxf(pmax, p1[r]);
    { auto rr = __builtin_amdgcn_permlane32_swap(__float_as_uint(pmax), __float_as_uint(pmax), false, false);
      pmax = fmaxf(__uint_as_float(rr[0]), __uint_as_float(rr[1])); }
    constexpr float C2 = 1.4426950408889634f * SCALE;
    if (__builtin_expect(__all((pmax - m_reg) * SCALE <= THR), 1)) { mn = m_reg; alpha = 1.f; }
    else { mn = fmaxf(m_reg, pmax); alpha = __builtin_amdgcn_exp2f((m_reg - mn) * C2); m_reg = mn; }
    const float mnL = -mn * C2;
#pragma unroll
    for (int r = 0; r < 16; ++r) p0[r] = fmaf(p0[r], C2, mnL);
#pragma unroll
    for (int r = 0; r < 16; ++r) p1[r] = fmaf(p1[r], C2, mnL);
#pragma unroll
    for (int r = 0; r < 16; ++r) p0[r] = __builtin_amdgcn_exp2f(p0[r]);
}
__device__ __forceinline__ void finishSM(f32x16& p0, f32x16& p1, float alpha, float& l_reg, bf16x8& pa0, bf16x8& pa1, bf16x8& pa2, bf16x8& pa3) {
#pragma unroll
    for (int r = 0; r < 16; ++r) p1[r] = __builtin_amdgcn_exp2f(p1[r]);
    float ps = 0;
#pragma unroll
    for (int r = 0; r < 16; ++r) ps += p0[r];
#pragma unroll
    for (int r = 0; r < 16; ++r) ps += p1[r];
    { auto rr = __builtin_amdgcn_permlane32_swap(__float_as_uint(ps), __float_as_uint(ps), false, false);
      ps = __uint_as_float(rr[0]) + __uint_as_float(rr[1]); }
    l_reg = l_reg * alpha + ps;
#define PK4(P, B_, OUT) do { unsigned a0 = cvtpk(P[B_+0], P[B_+1]), a1 = cvtpk(P[B_+2], P[B_+3]);                          \
        unsigned b0 = cvtpk(P[B_+4], P[B_+5]), b1 = cvtpk(P[B_+6], P[B_+7]);                                             \
        auto r0 = __builtin_amdgcn_permlane32_swap(a0, b0, false, false); auto r1 = __builtin_amdgcn_permlane32_swap(a1, b1, false, false); \
        u32x4 w = {r0[0], r1[0], r0[1], r1[1]}; OUT = *reinterpret_cast<bf16x8*>(&w); } while (0)
    PK4(p0, 0, pa0); PK4(p0, 8, pa1); PK4(p1, 0, pa2); PK4(p1, 8, pa3);
#undef PK4
}
template <int KB>
__device__ __forceinline__ void qkt(f32x16& p0, f32x16& p1, const char* K_lds, int r32, int hi, const bf16x8* qr) {
    p0 = f32x16{}; p1 = f32x16{};
    const char* kb[4];
#pragma unroll
    for (int dd = 0; dd < 4; ++dd) kb[dd] = K_lds + KB * SHM_K + KSWZ(r32, (dd * 16 + hi * 8) * 2);
#pragma unroll
    for (int d0 = 0; d0 < 8; ++d0) { const char* a = kb[d0 & 3] + (d0 >> 2) * 128;
        bf16x8 b0 = *reinterpret_cast<const bf16x8*>(a);
        bf16x8 b1 = *reinterpret_cast<const bf16x8*>(a + 32 * 256);
        p0 = __builtin_amdgcn_mfma_f32_32x32x16_bf16(b0, qr[d0], p0, 0, 0, 0);
        p1 = __builtin_amdgcn_mfma_f32_32x32x16_bf16(b1, qr[d0], p1, 0, 0, 0); }
}
template <int VB>
__device__ __forceinline__ void pv_tile(f32x16* o, int vb0, bf16x8 pa0, bf16x8 pa1, bf16x8 pa2, bf16x8 pa3) {
#define TRRD(dst, off) asm volatile("ds_read_b64_tr_b16 %0, %1 offset:%2" : "=&v"(dst) : "v"(vb0), "i"(off) : "memory")
#define PV_D0(d0) do { s16x4 l0, l1, l2, l3, h0, h1, h2, h3; constexpr int b_ = VB * SHM_V + v_rd_off(d0, 0, 0); \
        TRRD(l0, b_); TRRD(h0, b_ + 2048); TRRD(l1, b_ + 4096); TRRD(h1, b_ + 6144); TRRD(l2, b_ + 8192); TRRD(h2, b_ + 10240); TRRD(l3, b_ + 12288); TRRD(h3, b_ + 14336); \
        asm volatile("s_waitcnt lgkmcnt(0)" ::: "memory"); SBAR();   \
        o[d0] = __builtin_amdgcn_mfma_f32_32x32x16_bf16(pa0, (bf16x8){l0[0], l0[1], l0[2], l0[3], h0[0], h0[1], h0[2], h0[3]}, o[d0], 0, 0, 0);   \
        o[d0] = __builtin_amdgcn_mfma_f32_32x32x16_bf16(pa1, (bf16x8){l1[0], l1[1], l1[2], l1[3], h1[0], h1[1], h1[2], h1[3]}, o[d0], 0, 0, 0);   \
        o[d0] = __builtin_amdgcn_mfma_f32_32x32x16_bf16(pa2, (bf16x8){l2[0], l2[1], l2[2], l2[3], h2[0], h2[1], h2[2], h2[3]}, o[d0], 0, 0, 0);   \
        o[d0] = __builtin_amdgcn_mfma_f32_32x32x16_bf16(pa3, (bf16x8){l3[0], l3[1], l3[2], l3[3], h3[0], h3[1], h3[2], h3[3]}, o[d0], 0, 0, 0); } while (0)
    PV_D0(0); PV_D0(1); PV_D0(2); PV_D0(3);
#undef PV_D0
#undef TRRD
}

enum { M_CAUSAL = 0, M_FOX = 1, M_WIN = 2, M_SLC = 3, M_NONE = 4, M_CMP = 5 };
struct AttnArgs {
    const bf16_t* Q; const bf16_t* K; const bf16_t* V; bf16_t* O;
    int ldq, ldk, ldv, ldo;
    int P0, j_lo, j_hi;
    const float* cb;
    const u64* sel;
    const float* qg;
};
__device__ __forceinline__ bf16x8 ovl_frag(int j, int ks, int hi, int r32, int d0p) {
    const int jrel = (32 * d0p + r32) - 2 * (8 * j + 2 * ks + hi);
    const unsigned e0 = (jrel == 0) ? 0x3F80u : 0u, e3 = (jrel == 0 || jrel == 1) ? 0x3F00u : 0u, e4 = (jrel == 1) ? 0x3F80u : 0u, e7 = (jrel == 1 || jrel == 2) ? 0x3F00u : 0u;
    u32x4 w = {e0 | (e0 << 16), e0 | (e3 << 16), e4 | (e4 << 16), e4 | (e7 << 16)};
    return *reinterpret_cast<bf16x8*>(&w);
}

template <int MODE>
__device__ __forceinline__ void attn_block(char* lds, const AttnArgs& a, const int tid) {
    const int wid = __builtin_amdgcn_readfirstlane(tid >> 6), lane = tid & 63, r32 = lane & 31, hi = lane >> 5;
    const int NT = a.j_hi - a.j_lo;
    char* V_lds = lds; char* K_lds = lds + 2 * SHM_V;
    float* ws = (float*)(lds + ATT_SCR) + wid * 64; float* li_l = ws; float* al_l = ws + 32;
    float* cst = (float*)(lds + ATT_CST);
    const int qrow = (MODE == M_CMP) ? (8 * wid + (r32 & 7)) : (32 * wid + r32);
    const int qcol = (MODE == M_CMP) ? ((r32 >> 3) * HD) : 0;
    const int qpos = a.P0 + qrow;
    const int qlo = a.P0 + ((MODE == M_CMP) ? 8 * wid : 32 * wid);
    bf16x8 qr[8];
    { const bf16_t* qp = a.Q + (size_t)qrow * a.ldq + qcol + hi * 8;
#pragma unroll
      for (int d0 = 0; d0 < 8; ++d0) qr[d0] = *reinterpret_cast<const bf16x8*>(qp + d0 * 16); }
    if constexpr (MODE == M_NONE) {
        float ss = 0.f;
#pragma unroll
        for (int d0 = 0; d0 < 8; ++d0)
#pragma unroll
            for (int j = 0; j < 8; ++j) { const float f = bf2f((unsigned short)qr[d0][j]); ss += f * f; }
        { auto rr = __builtin_amdgcn_permlane32_swap(__float_as_uint(ss), __float_as_uint(ss), false, false); ss = __uint_as_float(rr[0]) + __uint_as_float(rr[1]); }
        const float rstd = rsqrtf(ss * (1.0f / HD) + EPS);
#pragma unroll
        for (int d0 = 0; d0 < 8; ++d0) { const f32x4 g0 = *(const f32x4*)(a.qg + d0 * 16 + hi * 8), g1 = *(const f32x4*)(a.qg + d0 * 16 + hi * 8 + 4);
            float f[8];
#pragma unroll
            for (int j = 0; j < 8; ++j) f[j] = bf2f((unsigned short)qr[d0][j]) * rstd * (j < 4 ? g0[j] : g1[j - 4]);
            u32x4 w = {cvtpk(f[0], f[1]), cvtpk(f[2], f[3]), cvtpk(f[4], f[5]), cvtpk(f[6], f[7])}; qr[d0] = *reinterpret_cast<bf16x8*>(&w); }
    }
    float cq_s = 0.f; unsigned sel_lo = 0, sel_hi = 0;
    if constexpr (MODE == M_FOX) cq_s = a.cb[qpos] * (1.0f / SCALE);
    if constexpr (MODE == M_SLC) { const u64 s = a.sel[qpos]; sel_lo = (unsigned)s; sel_hi = (unsigned)(s >> 32); }
    const int sr = tid >> 4, sc = (tid & 15) * 8, vst0 = v_st(sr, sc), vst1 = v_st(32 + sr, sc), kws = KSWZ(sr, sc * 2);
    const int vb0 = (int)(uintptr_t)V_lds + v_rd_base(lane);
    bf16x8 st_v0, st_v1, st_k0, st_k1; float st_c = 0.f;
#define SLOAD(k0) do { st_v0 = *reinterpret_cast<const bf16x8*>(a.V + (size_t)((k0) + sr) * a.ldv + sc); st_v1 = *reinterpret_cast<const bf16x8*>(a.V + (size_t)((k0) + 32 + sr) * a.ldv + sc); \
                       st_k0 = *reinterpret_cast<const bf16x8*>(a.K + (size_t)((k0) + sr) * a.ldk + sc); st_k1 = *reinterpret_cast<const bf16x8*>(a.K + (size_t)((k0) + 32 + sr) * a.ldk + sc); \
                       if constexpr (MODE == M_FOX) { if (tid < 64) st_c = a.cb[(k0) + tid]; } } while (0)
#define SWRITE(bf) do { *(bf16x8*)(V_lds + (bf) * SHM_V + vst0) = st_v0; *(bf16x8*)(V_lds + (bf) * SHM_V + vst1) = st_v1; \
                        *(bf16x8*)(K_lds + (bf) * SHM_K + kws) = st_k0; *(bf16x8*)(K_lds + (bf) * SHM_K + kws + 32 * 256) = st_k1; \
                        if constexpr (MODE == M_FOX) { if (tid < 64) cst[(bf) * 64 + tid] = st_c * (1.0f / SCALE); } } while (0)
    float m_reg = -1e30f, l_reg = 0.f; f32x16 o[4] = {}; f32x16 oi[2] = {};
    f32x16 p0, p1; float mn, alpha; bf16x8 pa0, pa1, pa2, pa3;
#define RESC(al) do { if (__any((al) < 1.f)) { if (hi == 0) al_l[r32] = (al); asm volatile("s_waitcnt lgkmcnt(0)" ::: "memory");              \
                     _Pragma("unroll") for (int r = 0; r < 16; ++r) { const float f_ = al_l[crow(r, hi)]; _Pragma("unroll") for (int d_ = 0; d_ < 4; ++d_) o[d_][r] *= f_; \
                        if constexpr (MODE == M_CMP) { oi[0][r] *= f_; oi[1][r] *= f_; } } } } while (0)
#define STEP(t, KB) do { \
        const int jt_ = a.j_lo + (t), kb_ = jt_ * KVBLK;                                                                              \
        SBAR(); qkt<KB>(p0, p1, K_lds, r32, hi, qr);                                                                                   \
        if ((t) + 1 < NT) { SLOAD(kb_ + KVBLK); }                                                                                      \
        if constexpr (MODE == M_FOX) {                                                                                                 \
            _Pragma("unroll") for (int q_ = 0; q_ < 4; ++q_) { const f32x4 c0_ = *(const f32x4*)(cst + (KB) * 64 + 8 * q_ + 4 * hi), c1_ = *(const f32x4*)(cst + (KB) * 64 + 32 + 8 * q_ + 4 * hi); \
                _Pragma("unroll") for (int j_ = 0; j_ < 4; ++j_) { p0[4 * q_ + j_] += cq_s - c0_[j_]; p1[4 * q_ + j_] += cq_s - c1_[j_]; } } }           \
        if constexpr (MODE == M_CAUSAL || MODE == M_FOX || MODE == M_SLC) { if (kb_ + KVBLK - 1 > qlo) mask_tile(p0, p1, qpos - 4 * hi - kb_, 0x7fffffffu); } \
        if constexpr (MODE == M_WIN) { if (kb_ + KVBLK - 1 > qlo || kb_ <= qlo + 31 - 512) mask_tile(p0, p1, qpos - 4 * hi - kb_, 512u); }      \
        if constexpr (MODE == M_CMP) { mask_tile(p0, p1, ((qpos - 31) >> 4) - 4 * hi - kb_, 0x80000000u); }                            \
        if constexpr (MODE == M_SLC) { const unsigned w_ = (jt_ < 32) ? sel_lo : sel_hi; if (((w_ >> (jt_ & 31)) & 1u) == 0u) {        \
                const float NEG_ = -__builtin_inff(); _Pragma("unroll") for (int r = 0; r < 16; ++r) { p0[r] = NEG_; p1[r] = NEG_; } } } \
        partialSM(p0, p1, m_reg, mn, alpha); finishSM(p0, p1, alpha, l_reg, pa0, pa1, pa2, pa3);                                       \
        RESC(alpha); SBAR();                                                                                                           \
        pv_tile<KB>(o, vb0, pa0, pa1, pa2, pa3);                                                                                       \
        if constexpr (MODE == M_CMP) {                                                                                                 \
            oi[0] = __builtin_amdgcn_mfma_f32_32x32x16_bf16(pa0, ovl_frag(jt_, 0, hi, r32, 0), oi[0], 0, 0, 0); oi[1] = __builtin_amdgcn_mfma_f32_32x32x16_bf16(pa0, ovl_frag(jt_, 0, hi, r32, 1), oi[1], 0, 0, 0); \
            oi[0] = __builtin_amdgcn_mfma_f32_32x32x16_bf16(pa1, ovl_frag(jt_, 1, hi, r32, 0), oi[0], 0, 0, 0); oi[1] = __builtin_amdgcn_mfma_f32_32x32x16_bf16(pa1, ovl_frag(jt_, 1, hi, r32, 1), oi[1], 0, 0, 0); \
            oi[0] = __builtin_amdgcn_mfma_f32_32x32x16_bf16(pa2, ovl_frag(jt_, 2, hi, r32, 0), oi[0], 0, 0, 0); oi[1] = __builtin_amdgcn_mfma_f32_32x32x16_bf16(pa2, ovl_frag(jt_, 2, hi, r32, 1), oi[1], 0, 0, 0); \
            oi[0] = __builtin_amdgcn_mfma_f32_32x32x16_bf16(pa3, ovl_frag(jt_, 3, hi, r32, 0), oi[0], 0, 0, 0); oi[1] = __builtin_amdgcn_mfma_f32_32x32x16_bf16(pa3, ovl_frag(jt_, 3, hi, r32, 1), oi[1], 0, 0, 0); } \
        if ((t) + 1 < NT) { VM_WAIT(); SWRITE((KB) ^ 1); }                                                                             \
        __syncthreads(); } while (0)
    SLOAD(a.j_lo * KVBLK); VM_WAIT(); SWRITE(0); __syncthreads();
    int t = 0;
    for (; t + 1 < NT; t += 2) { STEP(t, 0); STEP(t + 1, 1); }
    if (NT & 1) { STEP(NT - 1, 0); }
    if (hi == 0) li_l[r32] = l_reg; asm volatile("s_waitcnt lgkmcnt(0)" ::: "memory");
    float rli[16];
#pragma unroll
    for (int r = 0; r < 16; ++r) rli[r] = __builtin_amdgcn_rcpf(fmaxf(li_l[crow(r, hi)], 1e-30f));
#pragma unroll
    for (int r = 0; r < 16; ++r) { const int orow = crow(r, hi);
        bf16_t* Ow = (MODE == M_CMP) ? a.O + (size_t)(8 * wid + (orow & 7)) * a.ldo + (orow >> 3) * HD : a.O + (size_t)(32 * wid + orow) * a.ldo;
#pragma unroll
        for (int d0 = 0; d0 < 4; ++d0) { const float v = o[d0][r] * rli[r]; const float vn = __shfl_xor(v, 1);
            if ((r32 & 1) == 0) *(unsigned*)(Ow + d0 * 32 + r32) = cvtpk(v, vn); } }
    if constexpr (MODE == M_CMP) {
        float* imp = (float*)(lds + ATT_IMP);
#pragma unroll
        for (int rr = 0; rr < 4; ++rr)
#pragma unroll
            for (int d0p = 0; d0p < 2; ++d0p) { float v = 0.f;
#pragma unroll
                for (int q = 0; q < 4; ++q) v += oi[d0p][4 * q + rr] * rli[4 * q + rr];
                imp[(8 * wid + rr + 4 * hi) * 65 + 32 * d0p + r32] = v; }
        __syncthreads();
        if (tid < 64) { const int pos = a.P0 + tid, qb = pos >> 6; const float* im = imp + tid * 65;
            u64 mask = 1ull | (1ull << qb) | (qb >= 1 ? (1ull << (qb - 1)) : 0ull);
            if (qb - 2 <= 5) { for (int j = 1; j <= qb - 2; ++j) mask |= 1ull << j; }
            else { for (int k = 0; k < 5; ++k) { int best = 1; float bv = -1.f;
                    for (int j = 1; j <= qb - 2; ++j) { const float v = im[j]; if (((mask >> j) & 1ull) == 0ull && v > bv) { bv = v; best = j; } }
                    mask |= 1ull << best; } }
            ((u64*)a.sel)[pos] = mask; }
    }
    __syncthreads();
#undef STEP
#undef RESC
#undef SLOAD
#undef SWRITE
}
}

struct TrItem { const float* src; bf16_t* dst; int src_ld, dst_ld, nvalid; };
__device__ __forceinline__ void tr_load(f32x4 (&r)[8], const TrItem t, int lane) {
    const int c4 = (lane & 7) * 4, rr = lane >> 3; const float* p = t.src + (size_t)rr * t.src_ld + c4; const bool ok = c4 < t.nvalid;
#pragma unroll
    for (int i = 0; i < 8; ++i) r[i] = ok ? *(const f32x4*)(p + (size_t)(8 * i) * t.src_ld) : (f32x4){0.f, 0.f, 0.f, 0.f};
}
__device__ __forceinline__ void tr_store(const f32x4 (&r)[8], const TrItem t, LAS float* scr, int lane) {
    const int c4 = (lane & 7) * 4, rr = lane >> 3;
#pragma unroll
    for (int i = 0; i < 8; ++i) { LAS float* q = scr + (rr + 8 * i) * 33 + c4; q[0] = r[i].x; q[1] = r[i].y; q[2] = r[i].z; q[3] = r[i].w; }
    LDS_WAIT(); asm volatile("" ::: "memory");
    const int c = lane & 7;
#pragma unroll
    for (int j = 0; j < 4; ++j) { const int n = (lane >> 3) + 8 * j; const LAS float* s = scr + (8 * c) * 33 + n;
        u32x4 o; o.x = pk2(s[0 * 33], s[1 * 33]); o.y = pk2(s[2 * 33], s[3 * 33]); o.z = pk2(s[4 * 33], s[5 * 33]); o.w = pk2(s[6 * 33], s[7 * 33]);
        if (n < t.nvalid) *(u32x4*)(t.dst + (size_t)n * t.dst_ld + 8 * c) = o; }
    LDS_WAIT(); asm volatile("" ::: "memory");
}
template <class Dec>
__device__ __forceinline__ void tr_run(const Dec& D, int items, LAS float* scr, int gw, int NGW, int lane) {
    int it = gw; if (it >= items) return;
    f32x4 ra[8], rb[8];
    tr_load(ra, D(it), lane);
    for (;;) { const int nx = it + NGW; const bool hn = nx < items;
        if (hn) tr_load(rb, D(nx), lane);
        tr_store(ra, D(it), scr, lane);
        if (!hn) break;
        it = nx;
#pragma unroll
        for (int i = 0; i < 8; ++i) ra[i] = rb[i]; }
}
struct BlockDec { const float* W; bf16_t* WT; int src_ld, K, c0, ncols, drow0, nblk;
    __device__ __forceinline__ TrItem operator()(int it) const { TrItem t; const int kb = it / nblk, nb = it - kb * nblk, rem = ncols - 32 * nb;
        t.src = W + (size_t)(64 * kb) * src_ld + c0 + 32 * nb; t.dst = WT + (size_t)(drow0 + 32 * nb) * K + 64 * kb; t.src_ld = src_ld; t.dst_ld = K; t.nvalid = rem < 32 ? rem : 32; return t; } };
__device__ __forceinline__ void tr_block(const float* W, int src_ld, int K, int c0, int ncols, bf16_t* WT, int drow0, LAS float* scr, int gw, int NGW, int lane) {
    const int nblk = (ncols + 31) >> 5; BlockDec D{W, WT, src_ld, K, c0, ncols, drow0, nblk}; tr_run(D, (K >> 6) * nblk, scr, gw, NGW, lane);
}
__device__ __forceinline__ void zero_fill16(void* p, size_t bytes, int gtid, int NGT) {
    u32x4* q = (u32x4*)p; const size_t n = bytes >> 4; const u32x4 z = {0u, 0u, 0u, 0u};
    for (size_t i = gtid; i < n; i += NGT) q[i] = z;
}
struct Moe13Dec { const float* w1; const float* w3; bf16_t* W13;
    __device__ __forceinline__ TrItem operator()(int it) const { TrItem t; const int nb = it & 15, kb = (it >> 4) & 31, which = (it >> 9) & 1, e = it >> 10, c0 = nb * 32;
        t.src = (const float*)((uintptr_t)w1 + (uintptr_t)which * ((uintptr_t)w3 - (uintptr_t)w1)) + (size_t)e * DM * FF + (size_t)(64 * kb) * FF + c0; t.dst = W13 + (size_t)e * 1024 * DM + (size_t)((c0 >> 7) * 256 + which * 128 + (c0 & 127)) * DM + 64 * kb;
        t.src_ld = FF; t.dst_ld = DM; t.nvalid = 32; return t; } };
struct Moe2Dec { const float* w2; bf16_t* W2;
    __device__ __forceinline__ TrItem operator()(int it) const { TrItem t; const int nb = it & 63, kb = (it >> 6) & 7, e = it >> 9;
        t.src = w2 + (size_t)e * FF * DM + (size_t)(64 * kb) * DM + nb * 32; t.dst = W2 + (size_t)e * DM * FF + (size_t)(nb * 32) * FF + 64 * kb; t.src_ld = DM; t.dst_ld = FF; t.nvalid = 32; return t; } };
__device__ __forceinline__ void moe_convert(const float* w1, const float* w3, const float* w2, bf16_t* W13, bf16_t* W2, LAS float* scr, int gw, int NGW, int lane) {
    { Moe13Dec D{w1, w3, W13}; tr_run(D, 32768, scr, gw, NGW, lane); }
    { Moe2Dec D{w2, W2}; tr_run(D, 16384, scr, gw, NGW, lane); }
}
__device__ __forceinline__ void norm_row(const float* xrow, const float* g, bf16_t* orow, int lane) {
    const f32x4* xr = (const f32x4*)xrow + lane; const f32x4* gr = (const f32x4*)g + lane;
    f32x4 v[8]; float s = 0.f;
#pragma unroll
    for (int j = 0; j < 8; ++j) { v[j] = xr[64 * j]; s += (v[j].x * v[j].x + v[j].y * v[j].y) + (v[j].z * v[j].z + v[j].w * v[j].w); }
    const float rstd = rsqrtf(wave_sum(s) * (1.f / DM) + EPS);
    u32x2* o8 = (u32x2*)orow + lane;
#pragma unroll
    for (int j = 0; j < 8; ++j) { const f32x4 gg = gr[64 * j]; u32x2 w; w.x = pk2(v[j].x * rstd * gg.x, v[j].y * rstd * gg.y); w.y = pk2(v[j].z * rstd * gg.z, v[j].w * rstd * gg.w); o8[64 * j] = w; }
}
template <bool ROPE>
__device__ __forceinline__ void group_norm4(bf16_t* p, const float* g, int nact, const f32x2* rope_row, int lane) {
    const int c = lane & 15; const u32x4 raw = *(const u32x4*)(p + 8 * lane);
    float x[8]; x[0] = bf2f((unsigned short)raw.x); x[1] = bf2f((unsigned short)(raw.x >> 16)); x[2] = bf2f((unsigned short)raw.y); x[3] = bf2f((unsigned short)(raw.y >> 16));
    x[4] = bf2f((unsigned short)raw.z); x[5] = bf2f((unsigned short)(raw.z >> 16)); x[6] = bf2f((unsigned short)raw.w); x[7] = bf2f((unsigned short)(raw.w >> 16));
    float ss = 0.f;
#pragma unroll
    for (int j = 0; j < 8; ++j) ss += x[j] * x[j];
    ss += __shfl_xor(ss, 1); ss += __shfl_xor(ss, 2); ss += __shfl_xor(ss, 4); ss += __shfl_xor(ss, 8);
    const float rstd = rsqrtf(ss * (1.f / HD) + EPS);
    const f32x4 g0 = *(const f32x4*)(g + 8 * c), g1 = *(const f32x4*)(g + 8 * c + 4);
    float y[8];
#pragma unroll
    for (int j = 0; j < 8; ++j) y[j] = x[j] * rstd * (j < 4 ? g0[j] : g1[j - 4]);
    if constexpr (ROPE) {
        const f32x4* rp = (const f32x4*)(rope_row + 8 * (c & 7)); const float sgn = (c < 8) ? -1.f : 1.f;
#pragma unroll
        for (int q = 0; q < 4; ++q) { const f32x4 cs = rp[q];
            const float pa = __shfl_xor(y[2 * q], 8), pb = __shfl_xor(y[2 * q + 1], 8);
            y[2 * q] = y[2 * q] * cs.x + sgn * pa * cs.y; y[2 * q + 1] = y[2 * q + 1] * cs.z + sgn * pb * cs.w; }
    }
    if ((lane >> 4) < nact) { u32x4 w = {cvtpk(y[0], y[1]), cvtpk(y[2], y[3]), cvtpk(y[4], y[5]), cvtpk(y[6], y[7])}; *(u32x4*)(p + 8 * lane) = w; }
}

__device__ __forceinline__ int deal(int i, int G, int c) { return (i & 1) ? i * G + (G - 1 - c) : i * G + c; }

struct MoeOrder {
    const char* A; size_t tA; const char* Bt; size_t eB, tB; int nN, total, G, c; const LAS int* tstart;
    __device__ bool next(int i, pg8::Unit& u) const {
        const int L = i * G + c; if (L >= total) return false;
        const int rt = L / nN, pn = L - rt * nN; int e = 0;
        for (int k = 1; k < NEXP; ++k) e += (tstart[k] <= rt) ? 1 : 0;
        u.a = A + (size_t)rt * tA; u.b = Bt + (size_t)e * eB + (size_t)pn * tB; u.pm = rt; u.pn = pn; return true;
    }
};
struct CaKvOrder {
    const char* A; const char* Bt; int c;
    __device__ bool next(int i, pg8::Unit& u) const {
        if (i > 0 || c >= 32) return false;
        const int ll = c >> 4, pm = (c >> 2) & 3, pn = c & 3;
        u.a = A + ((size_t)ll * 1024 + 256 * pm) * DM * 2; u.b = Bt + ((size_t)ll * 1024 + 256 * pn) * DM * 2; u.pm = ll * 4 + pm; u.pn = pn; return true;
    }
};
struct CmpOrder {
    const char* Z; const char* Bt; int c;
    __device__ bool next(int i, pg8::Unit& u) const {
        if (i > 0 || c >= 64) return false;
        const int ks = c >> 4, kv = (c >> 3) & 1, bg = c & 7, b = bg >> 1, g = bg & 1;
        u.a = Z + ((size_t)(b * T + 8 * ks) * LDZ0 + ZKV + (kv * 2 + g) * HD) * 2; u.b = Bt + ((size_t)kv * 256 * 4096 + 1024 * ks) * 2; u.pm = c; u.pn = 0; return true;
    }
};

#ifndef ROUTE_TAU
#define ROUTE_TAU 0.02f
#endif
struct RouteDec { int grp, j0, j1; float w0, w1, margin; };
__device__ __forceinline__ RouteDec route_decide(const float* lg, const float* bg, const float* be) {
    RouteDec d; float gmax = -3.0e38f, g2 = -3.0e38f; int grp = 0;
    const float gl0 = lg[32] + bg[0], gl1 = lg[33] + bg[1], gl2 = lg[34] + bg[2], gl3 = lg[35] + bg[3];
#define RD_G(v, j) { const bool a_ = (v) > gmax, b_ = (v) > g2; g2 = a_ ? gmax : (b_ ? (v) : g2); grp = a_ ? (j) : grp; gmax = a_ ? (v) : gmax; }
    RD_G(gl0, 0) RD_G(gl1, 1) RD_G(gl2, 2) RD_G(gl3, 3)
#undef RD_G
    const float gsum = __expf(gl0 - gmax) + __expf(gl1 - gmax) + __expf(gl2 - gmax) + __expf(gl3 - gmax);
    const float ptop = 1.f / gsum;
    float v0 = -3.0e38f, v1 = -3.0e38f, v2 = -3.0e38f; int j0 = 0, j1 = 0;
#pragma unroll
    for (int j = 0; j < 8; ++j) { const float v = lg[grp * 8 + j] + be[grp * 8 + j];
        const bool a_ = v > v0, b_ = v > v1, c_ = v > v2;
        v2 = b_ ? v1 : (c_ ? v : v2); j1 = a_ ? j0 : (b_ ? j : j1); v1 = a_ ? v0 : (b_ ? v : v1); j0 = a_ ? j : j0; v0 = a_ ? v : v0; }
    const float e1 = __expf(v1 - v0); d.w0 = ptop / (1.f + e1); d.w1 = ptop * e1 / (1.f + e1);
    d.margin = fminf(gmax - g2, v1 - v2); d.grp = grp; d.j0 = j0; d.j1 = j1; return d;
}
struct Args { const float* in[27]; float* out; unsigned char* ws; int ph_lo, ph_hi; };
enum { I_X = 0, I_MEM, I_NORMG, I_EVIN, I_EVOUT, I_NSAG, I_CMPPE, I_CMPW1, I_CMPW2, I_DIFFG, I_DIFFLAM, I_DIFFSUB, I_ODIN, I_ODOUT, I_FOXB, I_FOXG,
       I_CAWQ, I_CAWKV, I_CAG, I_CAWO, I_MOEWG, I_MOEBG, I_MOEWE, I_MOEBE, I_MOEW1, I_MOEW3, I_MOEW2 };
constexpr int NPHASE = 34;

__device__ __forceinline__ const void* karg_ptr(int byte_off) {
    const __attribute__((address_space(4))) char* kp = (const __attribute__((address_space(4))) char*)__builtin_amdgcn_kernarg_segment_ptr();
    return *(const void* const volatile __attribute__((address_space(4)))*)(kp + byte_off);
}
__device__ __forceinline__ int karg_int(int byte_off) {
    const __attribute__((address_space(4))) char* kp = (const __attribute__((address_space(4))) char*)__builtin_amdgcn_kernarg_segment_ptr();
    return *(const volatile int __attribute__((address_space(4)))*)(kp + byte_off);
}
#define KIN(i) ((const float*)karg_ptr(8 * (i)))
#define PHASE_LOCALS \
    unsigned char* const ws = (unsigned char*)karg_ptr(224); float* const xs = (float*)karg_ptr(216); (void)xs; \
    const int tid = opaque((int)threadIdx.x), lane = tid & 63, wave = __builtin_amdgcn_readfirstlane(tid >> 6); (void)lane; (void)wave; \
    const int G = gridDim.x, bx = blockIdx.x; const int gw = bx * 8 + wave, NGW = G * 8, gtid = bx * 512 + tid, NGT = G * 512; (void)gw; (void)NGW; (void)gtid; (void)NGT; \
    LAS float* const scr = (LAS float*)(ldsl + wave * 16384); (void)scr; LAS int* const tstart = (LAS int*)(ldsl + MOE_OFF); (void)tstart; \
    unsigned* const ctl = (unsigned*)(ws + WS_CTL); (void)ctl
#define x_in KIN(I_X)
#define normg KIN(I_NORMG)
#define HB ((bf16_t*)(ws + WS_HB))
#define Z ((bf16_t*)(ws + WS_Z))
#define ROPE ((const f32x2*)(ws + WS_ROPE))
#define CMPPART ((float*)(ws + WS_MISC))
#define CMPBIAS ((float*)(ws + WS_MISC + 65536))
#define GATES ((float*)(ws + WS_GATES))
#define SEL ((u64*)(ws + WS_SEL))
#define CBUF ((float*)(ws + WS_CBUF))
#define R_EID ((int*)(ws + WS_ROUTE))
#define R_WT ((float*)(ws + WS_ROUTE + 131072))
#define R_RANK ((int*)(ws + WS_ROUTE + 262144))
#define R_SLOT ((int*)(ws + WS_ROUTE + 393216))
#define KC ((bf16_t*)(ws + WS_KC))
#define VC ((bf16_t*)(ws + WS_VC))
#define HID ((bf16_t*)(ws + WS_HID))
#define CAKV ((bf16_t*)(ws + WS_CAKV))
#define MEMN ((bf16_t*)(ws + WS_MEMN))
#define W_EVIN ((bf16_t*)(ws + WS_W_EVIN))
#define W_EVOUT ((bf16_t*)(ws + WS_W_EVOUT))
#define W_CMP1 ((bf16_t*)(ws + WS_W_CMP1))
#define W_ODIN ((bf16_t*)(ws + WS_W_ODIN))
#define W_ODOUT ((bf16_t*)(ws + WS_W_ODOUT))
#define W_CAQ ((bf16_t*)(ws + WS_W_CAQ))
#define W_CAKV ((bf16_t*)(ws + WS_W_CAKV))
#define W_CAO ((bf16_t*)(ws + WS_W_CAO))
#define W_RT ((bf16_t*)(ws + WS_W_RT))
#define W_M13 ((bf16_t*)(ws + WS_W_M13))
#define W_M2 ((bf16_t*)(ws + WS_W_M2))
#define OC ((bf16_t*)(ws + WS_OC))
#define OS ((bf16_t*)(ws + WS_OS))
#define OW ((bf16_t*)(ws + WS_OW))
#define O1 ((bf16_t*)(ws + WS_O1))
#define O2 ((bf16_t*)(ws + WS_O2))
#define OMIX ((bf16_t*)(ws + WS_OMIX))
#define CAQ ((bf16_t*)(ws + WS_CAQ))
#define OCA ((bf16_t*)(ws + WS_OCA))
#define LOGITS ((float*)(ws + WS_LOGITS))
#define XS ((bf16_t*)(ws + WS_XS))
#define HM ((bf16_t*)(ws + WS_HM))
#define YB ((bf16_t*)(ws + WS_YB))

__global__ void __launch_bounds__(512, 2) mk_fwd(Args args) {
    extern __shared__ __attribute__((aligned(16))) unsigned char lds[];
    LAS unsigned char* const ldsl = (LAS unsigned char*)lds;
    { const int t0 = threadIdx.x;
      for (int u = t0; u < (LDS_BYTES - MISC_OFF) / 4; u += 512) ((LAS unsigned*)(ldsl + MISC_OFF))[u] = 0u;
      __syncthreads();
      (void)xcd_barrier_post((unsigned*)((unsigned char*)karg_ptr(224) + WS_CTL) + CW_BAR, (volatile LAS unsigned*)(ldsl + MISC_OFF + 32)); }
    const int lo = karg_int(232), hi = karg_int(236);
#ifndef ONLY
#define ONLY (-1)
#endif
#ifndef REPEAT
#define REPEAT (-1)
#endif
#define NREP(k) ((REPEAT == (k)) ? 2 : 1)
#define PHM(k) (ONLY < 0 || ONLY == (k))
#define IN(k) (PHM(k) && lo <= (k) && (k) < hi)
#define INC(j) (PHM(100 + (j)) && lo <= (cb + (j)) && (cb + (j)) < hi)
#define SEAM(k) do { if (lo <= (k) && (k) + 1 < hi) { XcdBarrier b_; b_.bar = (unsigned*)((unsigned char*)karg_ptr(224) + WS_CTL) + CW_BAR; b_.x = xb_xcc_id(); b_.st = (volatile LAS unsigned*)(ldsl + MISC_OFF + 32); xcd_barrier(b_); } } while (0)

    for (int l = 0; l < 2; ++l) {
      if (l == 0) {
        for (int rep_ = 0; rep_ < (IN(0) ? NREP(0) : 0); ++rep_) { PHASE_LOCALS;
            const float* ev_in = KIN(I_EVIN);
            tr_block(ev_in, 5656, DM, 0, 2560, W_EVIN, 0, scr, gw, NGW, lane);
            tr_block(ev_in, 5656, DM, 2584, 3072, W_EVIN, 2560, scr, gw, NGW, lane);
            tr_block(ev_in, 5656, DM, 2560, 24, W_EVIN, 5632, scr, gw, NGW, lane);
            zero_fill16(W_EVIN + (size_t)5656 * DM, (size_t)(LDZ0 - 5656) * DM * 2, gtid, NGT);
            tr_block(KIN(I_EVOUT), DM, DM, 0, DM, W_EVOUT, 0, scr, gw, NGW, lane);
            for (int kv = 0; kv < 2; ++kv) tr_block(KIN(I_CMPW1) + (size_t)kv * 4096 * 256, 256, 4096, 0, 256, W_CMP1 + (size_t)kv * 256 * 4096, 0, scr, gw, NGW, lane);
            tr_block(KIN(I_ODIN), 6160, DM, 0, 6160, W_ODIN, 0, scr, gw, NGW, lane);
            zero_fill16(W_ODIN + (size_t)6160 * DM, (size_t)(LDZ1 - 6160) * DM * 2, gtid, NGT);
            tr_block(KIN(I_ODOUT), DM, DM, 0, DM, W_ODOUT, 0, scr, gw, NGW, lane);
            for (int ll = 0; ll < 2; ++ll) {
                tr_block(KIN(I_CAWQ) + (size_t)ll * DM * 512, 512, DM, 0, 512, W_CAQ + (size_t)ll * 512 * DM, 0, scr, gw, NGW, lane);
                tr_block(KIN(I_CAWKV) + (size_t)ll * DM * 1024, 1024, DM, 0, 1024, W_CAKV + (size_t)ll * 1024 * DM, 0, scr, gw, NGW, lane);
                tr_block(KIN(I_CAWO) + (size_t)ll * 512 * DM, DM, 512, 0, DM, W_CAO + (size_t)ll * DM * 512, 0, scr, gw, NGW, lane);
                tr_block(KIN(I_MOEWE) + (size_t)ll * DM * 32, 32, DM, 0, 32, W_RT + (size_t)ll * 256 * DM, 0, scr, gw, NGW, lane);
                tr_block(KIN(I_MOEWG) + (size_t)ll * DM * 4, 4, DM, 0, 4, W_RT + (size_t)ll * 256 * DM, 32, scr, gw, NGW, lane);
                zero_fill16(W_RT + (size_t)ll * 256 * DM + (size_t)36 * DM, (size_t)220 * DM * 2, gtid, NGT);
            }
            moe_convert(KIN(I_MOEW1), KIN(I_MOEW3), KIN(I_MOEW2), W_M13, W_M2, scr, gw, NGW, lane);
            for (int i = gtid; i < T * 64; i += NGT) { const int pos = i >> 6, k = i & 63;
                const float inv = exp2f(-(float)k * (13.287712379549449f / 64.0f)); const float ang = (float)pos * inv;
                const double a = (double)ang, kk = rint(a * 0.15915494309189535); const float r = (float)(a - kk * 6.283185307179586);
                f32x2 cs; cs.x = __cosf(r); cs.y = __sinf(r); ((f32x2*)(ws + WS_ROPE))[i] = cs; }
            for (int tsk = gw; tsk < 256; tsk += NGW) { const int cblk = tsk & 3, chunk = (tsk >> 2) & 31, kv = tsk >> 7; const int c = cblk * 64 + lane;
                const float* pe = KIN(I_CMPPE) + (size_t)kv * 4096 + chunk * 128; const float* w = KIN(I_CMPW1) + (size_t)kv * 4096 * 256 + (size_t)chunk * 128 * 256 + c;
                float s = 0.f;
#pragma unroll 8
                for (int k = 0; k < 128; ++k) s += pe[k] * w[(size_t)k * 256];
                CMPPART[(kv * 32 + chunk) * 256 + c] = s; }
            for (int m = gw; m < NTOK; m += NGW) norm_row(x_in + (size_t)m * DM, normg + 0 * DM, HB + (size_t)m * DM, lane);
            for (int m = gw; m < 2048; m += NGW) { const int ll = m >> 10, r = m & 1023; norm_row(KIN(I_MEM) + (size_t)r * DM, normg + (size_t)(ll * 4 + 2) * DM, MEMN + (size_t)m * DM, lane); }
        }
        SEAM(0);
        for (int rep_ = 0; rep_ < (IN(1) ? NREP(1) : 0); ++rep_) { PHASE_LOCALS;
            if (bx == 0) { const int kv = tid >> 8, c = tid & 255; float s = 0.f; for (int ch = 0; ch < 32; ++ch) s += CMPPART[(kv * 32 + ch) * 256 + c]; CMPBIAS[kv * 256 + c] = s; }
            { pg8::Dims g{DM, DM * 2, DM * 2, 0}; pg8::DenseOrder S; S.init(HB, W_EVIN, NTOK, LDZ0, DM * 2, DM * 2, G, bx); pg8::EpiBf16 E{Z, LDZ0};
              pg8::gemm_phase<pg8::EpiBf16, pg8::DenseOrder>(ldsl, g, S, E, tid); }
            { pg8::Dims g{DM, DM * 2, DM * 2, 0}; CaKvOrder S{(const char*)MEMN, (const char*)W_CAKV, (bx + 64) & 255}; pg8::EpiBf16 E{CAKV, 1024};
              pg8::gemm_phase<pg8::EpiBf16, CaKvOrder>(ldsl, g, S, E, tid); }
        }
        SEAM(1);
        for (int rep_ = 0; rep_ < (IN(2) ? NREP(2) : 0); ++rep_) { PHASE_LOCALS;
            { pg8::Dims g{1024, 16 * LDZ0 * 2, 4096 * 2, LDZ0 * 2}; CmpOrder S{(const char*)Z, (const char*)W_CMP1, bx}; pg8::EpiF32 E{(float*)(ws + WS_LOGITS), nullptr, 256};
              pg8::gemm_phase<pg8::EpiF32, CmpOrder, true>(ldsl, g, S, E, tid); }
            const float* nsag = KIN(I_NSAG); const float* dg = KIN(I_DIFFG);
            const int gw2 = (G > 128) ? (bx - 64) * 8 + wave : gw, NGW2 = (G > 128) ? (G - 64) * 8 : NGW;
            for (int m = (gw2 < 0 ? NTOK : gw2); m < NTOK; m += NGW2) { bf16_t* zr = Z + (size_t)m * LDZ0; const f32x2* rr = ROPE + (size_t)(m & (T - 1)) * 64;
                group_norm4<true>(zr + ZQ, nsag, 4, rr, lane); group_norm4<true>(zr + ZQ + 512, nsag, 4, rr, lane);
                group_norm4<true>(zr + ZKV + 4 * HD, nsag + 2 * HD, 2, rr, lane); group_norm4<true>(zr + ZKV + 8 * HD, nsag + 3 * HD, 2, rr, lane);
                group_norm4<true>(zr + ZDQ, dg, 4, rr, lane); group_norm4<true>(zr + ZDQ + 512, dg, 4, rr, lane);
                group_norm4<true>(zr + ZDK, dg + HD, 4, rr, lane); group_norm4<true>(zr + ZDK + 512, dg + HD, 4, rr, lane);
                if (lane < 24) GATES[(size_t)m * 24 + lane] = 1.f / (1.f + __expf(-bf2f(zr[ZG + lane]))); }
            for (int row = gw; row < 2048; row += NGW) { const int ll = row >> 10; group_norm4<false>(CAKV + (size_t)row * 1024, KIN(I_CAG) + (ll * 2 + 1) * HD, 4, nullptr, lane); }
        }
        SEAM(2);
        for (int rep_ = 0; rep_ < (IN(3) ? NREP(3) : 0); ++rep_) { PHASE_LOCALS;
            for (int m = gw; m < 2 * 2048; m += NGW) { const int kv = m >> 11, row = m & 2047, bg = row >> 8, n = row & 255;
                bf16_t* dst = (kv ? VC : KC) + (size_t)row * HD;
                if (n == 255) { dst[lane] = 0; dst[64 + lane] = 0; continue; }
                const float* w2 = KIN(I_CMPW2) + (size_t)kv * 256 * HD; const float* slab = (const float*)(ws + WS_LOGITS) + ((size_t)(kv * 8 + bg) * 256 + n) * 256 + 4 * lane;
                f32x4 hs = *(const f32x4*)(CMPBIAS + kv * 256 + 4 * lane);
#pragma unroll
                for (int ks = 0; ks < 4; ++ks) hs += *(const f32x4*)(slab + (size_t)ks * 16 * 256 * 256);
                float hv[4];
#pragma unroll
                for (int j = 0; j < 4; ++j) { const float xx = hs[j]; const float uu = 1.5957691216f * (xx + 0.044715f * xx * xx * xx); hv[j] = bf2f((unsigned short)f2bf(xx / (1.0f + __expf(-uu)))); }
                float a0 = 0.f, a1 = 0.f;
                for (int j4 = 0; j4 < 64; ++j4) {
#pragma unroll
                    for (int jj = 0; jj < 4; ++jj) { const float hj = __shfl(hv[jj], j4); const float* wr_ = w2 + (size_t)(4 * j4 + jj) * HD; a0 += hj * wr_[lane]; a1 += hj * wr_[64 + lane]; } }
                if (kv == 0) { const float rstd = rsqrtf(wave_sum(a0 * a0 + a1 * a1) * (1.f / HD) + EPS); const float* gk = KIN(I_NSAG) + HD;
                    const float y0 = a0 * rstd * gk[lane], y1 = a1 * rstd * gk[64 + lane]; const f32x2 cs = ROPE[(size_t)(16 * n + 31) * 64 + lane];
                    a0 = y0 * cs.x - y1 * cs.y; a1 = y1 * cs.x + y0 * cs.y; }
                dst[lane] = (bf16_t)f2bf(a0); dst[64 + lane] = (bf16_t)f2bf(a1); (void)bg; }
        }
        SEAM(3);
        for (int rep_ = 0; rep_ < (IN(4) ? NREP(4) : 0); ++rep_) { PHASE_LOCALS; const int tq = tid;
            for (int i = 0;; ++i) { const int idx = deal(i, G, bx); if (idx >= 512) break;
                const int tb = 63 - (idx >> 3), rest = idx & 7, b = rest >> 1, g2 = rest & 1, P0 = 64 * tb;
                att::AttnArgs a; a.Q = Z + (size_t)(b * T + P0) * LDZ0 + ZQ + g2 * 4 * HD; a.ldq = LDZ0; a.K = KC + (size_t)(b * 2 + g2) * 256 * HD; a.V = VC + (size_t)(b * 2 + g2) * 256 * HD; a.ldk = HD; a.ldv = HD;
                a.O = OC + (size_t)(b * T + P0) * 1024 + g2 * 4 * HD; a.ldo = 1024; a.P0 = P0; a.j_lo = 0; a.j_hi = (((P0 + 32) >> 4) >> 6) + 1; a.cb = nullptr; a.sel = SEL + (size_t)(b * 2 + g2) * T; a.qg = nullptr;
                att::attn_block<att::M_CMP>((char*)lds, a, tq); }
        }
        SEAM(4);
        for (int rep_ = 0; rep_ < (IN(5) ? NREP(5) : 0); ++rep_) { PHASE_LOCALS; const int tq = tid;
            for (int i = 0;; ++i) { const int idx = deal(i, G, bx); if (idx >= 2048) break;
                att::AttnArgs a; a.cb = nullptr; a.sel = nullptr; a.qg = nullptr; a.ldq = LDZ0; a.ldk = LDZ0; a.ldv = LDZ0; a.ldo = 1024; a.j_lo = 0;
                if (idx < 1536) { const int qb = 15 - idx / 96, r = idx % 96; a.P0 = qb * 256; a.j_hi = 4 * (qb + 1);
                    if (r < 64) { const int b = r >> 4, h = (r >> 2) & 3, m = (r >> 1) & 1, vh = r & 1; const bf16_t* zb = Z + (size_t)(b * T) * LDZ0;
                        a.Q = zb + (size_t)a.P0 * LDZ0 + ZDQ + (h * 2 + m) * HD; a.K = zb + ZDK + (h * 2 + m) * HD; a.V = zb + ZDV + h * 256 + vh * HD;
                        a.O = (m ? O2 : O1) + (size_t)(b * T + a.P0) * 1024 + h * 256 + vh * HD;
                        att::attn_block<att::M_CAUSAL>((char*)lds, a, tq); }
                    else { const int r2 = r - 64, b = r2 >> 3, hq = r2 & 7, g2 = hq >> 2; const bf16_t* zb = Z + (size_t)(b * T) * LDZ0;
                        a.Q = zb + (size_t)a.P0 * LDZ0 + ZQ + hq * HD; a.K = zb + ZKV + (4 + g2) * HD; a.V = zb + ZKV + (6 + g2) * HD;
                        a.O = OS + (size_t)(b * T + a.P0) * 1024 + hq * HD; a.sel = SEL + (size_t)(b * 2 + g2) * T;
                        att::attn_block<att::M_SLC>((char*)lds, a, tq); } }
                else { const int r = idx - 1536, qb = 15 - (r >> 5), r2 = r & 31, b = r2 >> 3, hq = r2 & 7, g2 = hq >> 2; const bf16_t* zb = Z + (size_t)(b * T) * LDZ0;
                    a.P0 = qb * 256; a.j_hi = 4 * (qb + 1); a.j_lo = (a.P0 - 511) > 0 ? ((a.P0 - 511) >> 6) : 0;
                    a.Q = zb + (size_t)a.P0 * LDZ0 + ZQ + hq * HD; a.K = zb + ZKV + (8 + g2) * HD; a.V = zb + ZKV + (10 + g2) * HD;
                    a.O = OW + (size_t)(b * T + a.P0) * 1024 + hq * HD;
                    att::attn_block<att::M_WIN>((char*)lds, a, tq); } }
        }
        SEAM(5);
        for (int rep_ = 0; rep_ < (IN(6) ? NREP(6) : 0); ++rep_) { PHASE_LOCALS;
            const float* lamp = KIN(I_DIFFLAM); const float* subg = KIN(I_DIFFSUB);
            const float s1 = wave_sum(lamp[lane] * lamp[HD + lane] + lamp[64 + lane] * lamp[HD + 64 + lane]);
            const float s2 = wave_sum(lamp[2 * HD + lane] * lamp[3 * HD + lane] + lamp[2 * HD + 64 + lane] * lamp[3 * HD + 64 + lane]);
            const float lam_init = 0.2f, lam = __expf(s1) - __expf(s2) + lam_init;
            for (int m = gw; m < NTOK; m += NGW) { const size_t ro = (size_t)m * 1024; bf16_t* om = OMIX + (size_t)m * DM;
                for (int hq = 0; hq < 8; ++hq) { const float gc = GATES[(size_t)m * 24 + hq * 3], gs = GATES[(size_t)m * 24 + hq * 3 + 1], gwn = GATES[(size_t)m * 24 + hq * 3 + 2];
                    const unsigned c = *(const unsigned*)(OC + ro + hq * HD + 2 * lane), s = *(const unsigned*)(OS + ro + hq * HD + 2 * lane), w = *(const unsigned*)(OW + ro + hq * HD + 2 * lane);
                    const float v0 = gc * bf2f((unsigned short)c) + gs * bf2f((unsigned short)s) + gwn * bf2f((unsigned short)w);
                    const float v1 = gc * bf2f((unsigned short)(c >> 16)) + gs * bf2f((unsigned short)(s >> 16)) + gwn * bf2f((unsigned short)(w >> 16));
                    *(unsigned*)(om + hq * HD + 2 * lane) = pk2(v0, v1); }
                for (int h = 0; h < 4; ++h) { const u32x2 a1 = *(const u32x2*)(O1 + ro + h * 256 + 4 * lane), a2 = *(const u32x2*)(O2 + ro + h * 256 + 4 * lane);
                    float v[4]; v[0] = bf2f((unsigned short)a1.x) - lam * bf2f((unsigned short)a2.x); v[1] = bf2f((unsigned short)(a1.x >> 16)) - lam * bf2f((unsigned short)(a2.x >> 16));
                    v[2] = bf2f((unsigned short)a1.y) - lam * bf2f((unsigned short)a2.y); v[3] = bf2f((unsigned short)(a1.y >> 16)) - lam * bf2f((unsigned short)(a2.y >> 16));
                    const float rstd = rsqrtf(wave_sum((v[0] * v[0] + v[1] * v[1]) + (v[2] * v[2] + v[3] * v[3])) * (1.f / 256.f) + EPS) * (1.f - lam_init);
                    const f32x4 sg = *(const f32x4*)(subg + 4 * lane);
                    u32x2 w; w.x = pk2(v[0] * rstd * sg.x, v[1] * rstd * sg.y); w.y = pk2(v[2] * rstd * sg.z, v[3] * rstd * sg.w);
                    *(u32x2*)(om + 1024 + h * 256 + 4 * lane) = w; } }
        }
        SEAM(6);
        for (int rep_ = 0; rep_ < (IN(7) ? NREP(7) : 0); ++rep_) { PHASE_LOCALS; pg8::Dims g{DM, DM * 2, DM * 2, 0}; pg8::DenseOrder S; S.init(OMIX, W_EVOUT, NTOK, DM, DM * 2, DM * 2, G, bx); pg8::EpiF32 E{xs, x_in, DM};
            pg8::gemm_phase<pg8::EpiF32, pg8::DenseOrder>(ldsl, g, S, E, tid); }
        SEAM(7);
      } else {
        for (int rep_ = 0; rep_ < (IN(19) ? NREP(19) : 0); ++rep_) { PHASE_LOCALS; pg8::Dims g{DM, DM * 2, DM * 2, 0}; pg8::DenseOrder S; S.init(HB, W_ODIN, NTOK, LDZ1, DM * 2, DM * 2, G, bx); pg8::EpiBf16 E{Z, LDZ1};
            pg8::gemm_phase<pg8::EpiBf16, pg8::DenseOrder>(ldsl, g, S, E, tid); }
        SEAM(19);
        for (int rep_ = 0; rep_ < (IN(20) ? NREP(20) : 0); ++rep_) { PHASE_LOCALS;
            const float* fg = KIN(I_FOXG);
            for (int m = gw; m < NTOK; m += NGW) { bf16_t* zr = Z + (size_t)m * LDZ1;
#pragma unroll
                for (int q = 0; q < 4; ++q) { group_norm4<false>(zr + Z1Q + q * 512, fg, 4, nullptr, lane); group_norm4<false>(zr + Z1K + q * 512, fg + HD, 4, nullptr, lane); } }
            for (int sq = bx; sq < 64; sq += G) { const int b = sq >> 4, h = sq & 15; const float fb = KIN(I_FOXB)[h];
                const bf16_t* zc = Z + (size_t)(b * T + 8 * tid) * LDZ1 + Z1F + h; float lf[8];
#pragma unroll
                for (int i = 0; i < 8; ++i) lf[i] = bf2f(zc[(size_t)i * LDZ1]);
#pragma unroll
                for (int i = 0; i < 8; ++i) { const float v = lf[i] + fb; lf[i] = fminf(v, 0.f) - log1pf(__expf(-fabsf(v))); }
#pragma unroll
                for (int i = 1; i < 8; ++i) lf[i] += lf[i - 1];
                float incl = lf[7];
#pragma unroll
                for (int o = 1; o < 64; o <<= 1) { const float tv = __shfl_up(incl, o); if (lane >= o) incl += tv; }
                LAS float* wt = (LAS float*)ldsl;
                __syncthreads();
                if (lane == 63) wt[wave] = incl;
                __syncthreads();
                float base = incl - lf[7];
                for (int w = 0; w < wave; ++w) base += wt[w];
                float* cbp = CBUF + (size_t)sq * T + 8 * tid;
                *(f32x4*)cbp = (f32x4){base + lf[0], base + lf[1], base + lf[2], base + lf[3]}; *(f32x4*)(cbp + 4) = (f32x4){base + lf[4], base + lf[5], base + lf[6], base + lf[7]}; }
        }
        SEAM(20);
        for (int rep_ = 0; rep_ < (IN(21) ? NREP(21) : 0); ++rep_) { PHASE_LOCALS; const int tq = tid;
            for (int i = 0;; ++i) { const int idx = deal(i, G, bx); if (idx >= 1024) break;
                const int qb = 15 - (idx >> 6), r = idx & 63, b = r >> 4, h = r & 15; const bf16_t* zb = Z + (size_t)(b * T) * LDZ1;
                att::AttnArgs a; a.ldq = LDZ1; a.ldk = LDZ1; a.ldv = LDZ1; a.ldo = DM; a.P0 = qb * 256; a.j_lo = 0; a.j_hi = 4 * (qb + 1); a.sel = nullptr; a.qg = nullptr;
                a.Q = zb + (size_t)a.P0 * LDZ1 + Z1Q + h * HD; a.K = zb + Z1K + h * HD; a.V = zb + Z1V + h * HD; a.O = OMIX + (size_t)(b * T + a.P0) * DM + h * HD; a.cb = CBUF + (size_t)(b * 16 + h) * T;
                att::attn_block<att::M_FOX>((char*)lds, a, tq); }
        }
        SEAM(21);
        for (int rep_ = 0; rep_ < (IN(22) ? NREP(22) : 0); ++rep_) { PHASE_LOCALS; pg8::Dims g{DM, DM * 2, DM * 2, 0}; pg8::DenseOrder S; S.init(OMIX, W_ODOUT, NTOK, DM, DM * 2, DM * 2, G, bx); pg8::EpiF32 E{xs, xs, DM};
            pg8::gemm_phase<pg8::EpiF32, pg8::DenseOrder>(ldsl, g, S, E, tid); }
        SEAM(22);
      }
      const int cb = l ? 23 : 8;
      for (int rep_ = 0; rep_ < (INC(0) ? NREP(100 + 0) : 0); ++rep_) { PHASE_LOCALS; for (int m = gw; m < NTOK; m += NGW) norm_row(xs + (size_t)m * DM, normg + (size_t)(l * 4 + 1) * DM, HB + (size_t)m * DM, lane); }
      SEAM(cb + 0);
      for (int rep_ = 0; rep_ < (INC(1) ? NREP(100 + 1) : 0); ++rep_) { PHASE_LOCALS; pg8::Dims g{DM, DM * 2, DM * 2, 0}; pg8::DenseOrder S; S.init(HB, W_CAQ + (size_t)l * 512 * DM, NTOK, 512, DM * 2, DM * 2, G, bx); pg8::EpiBf16 E{CAQ, 512};
          pg8::gemm_phase<pg8::EpiBf16, pg8::DenseOrder>(ldsl, g, S, E, tid); }
      SEAM(cb + 1);
      for (int rep_ = 0; rep_ < (INC(2) ? NREP(100 + 2) : 0); ++rep_) { PHASE_LOCALS; const int tq = tid;
          for (int i = 0;; ++i) { const int idx = i * G + bx; if (idx >= 256) break;
              const int b = idx >> 6, h = (idx >> 4) & 3, qb = idx & 15; const bf16_t* kvb = CAKV + (size_t)l * 1024 * 1024 + (size_t)b * 256 * 1024;
              att::AttnArgs a; a.ldq = 512; a.ldk = 1024; a.ldv = 1024; a.ldo = 512; a.P0 = qb * 256; a.j_lo = 0; a.j_hi = 4; a.cb = nullptr; a.sel = nullptr; a.qg = KIN(I_CAG) + (l * 2) * HD;
              a.Q = CAQ + (size_t)(b * T + a.P0) * 512 + h * HD; a.K = kvb + h * HD; a.V = kvb + 512 + h * HD; a.O = OCA + (size_t)(b * T + a.P0) * 512 + h * HD;
              att::attn_block<att::M_NONE>((char*)lds, a, tq); }
      }
      SEAM(cb + 2);
      for (int rep_ = 0; rep_ < (INC(3) ? NREP(100 + 3) : 0); ++rep_) { PHASE_LOCALS; pg8::Dims g{512, 512 * 2, 512 * 2, 0}; pg8::DenseOrder S; S.init(OCA, W_CAO + (size_t)l * DM * 512, NTOK, DM, 512 * 2, 512 * 2, G, bx); pg8::EpiF32 E{xs, xs, DM};
          pg8::gemm_phase<pg8::EpiF32, pg8::DenseOrder>(ldsl, g, S, E, tid); }
      SEAM(cb + 3);
      for (int rep_ = 0; rep_ < (INC(4) ? NREP(100 + 4) : 0); ++rep_) { PHASE_LOCALS; for (int m = gw; m < NTOK; m += NGW) norm_row(xs + (size_t)m * DM, normg + (size_t)(l * 4 + 3) * DM, HB + (size_t)m * DM, lane); }
      SEAM(cb + 4);
      for (int rep_ = 0; rep_ < (INC(5) ? NREP(100 + 5) : 0); ++rep_) { PHASE_LOCALS; pg8::Dims g{DM, DM * 2, DM * 2, 0}; pg8::DenseOrder S; S.init(HB, W_RT + (size_t)l * 256 * DM, NTOK, 256, DM * 2, DM * 2, G, bx); pg8::EpiF32 E{LOGITS, nullptr, 256};
          pg8::gemm_phase<pg8::EpiF32, pg8::DenseOrder>(ldsl, g, S, E, tid); }
      SEAM(cb + 5);
      for (int rep_ = 0; rep_ < (INC(6) ? 1 : 0); ++rep_) { PHASE_LOCALS;
          const float* bg = KIN(I_MOEBG) + l * 4; const float* be = KIN(I_MOEBE) + l * 32; unsigned* cnt = ctl + CW_CNT + 2048 * l;
          LAS int* flist = (LAS int*)ldsl; LAS int* fcnt = (LAS int*)(ldsl + 1024); LAS int* dec_e = (LAS int*)(ldsl + 2048); LAS float* dec_w = (LAS float*)(ldsl + 3072);
          LAS int* lcnt = (LAS int*)(ldsl + 4096); LAS int* lbase = (LAS int*)(ldsl + 4096 + 128);
          for (int m0 = bx * 64; m0 < NTOK; m0 += G * 64) {
              if (tid == 0) *fcnt = 0;
              if (tid < 32) lcnt[tid] = 0;
              __syncthreads();
              if (tid < 64) { const int m = m0 + tid; const RouteDec d = route_decide(LOGITS + (size_t)m * 256, bg, be);
                  dec_e[2 * tid] = d.grp * 8 + d.j0; dec_e[2 * tid + 1] = d.grp * 8 + d.j1; dec_w[2 * tid] = d.w0; dec_w[2 * tid + 1] = d.w1;
                  (void)flist; (void)fcnt; }
              __syncthreads();
              int e_ = 0, lr_ = 0;
              if (tid < 128) { e_ = dec_e[tid]; lr_ = __hip_atomic_fetch_add(lcnt + e_, 1, __ATOMIC_RELAXED, __HIP_MEMORY_SCOPE_WORKGROUP); }
              __syncthreads();
              if (tid < 32) { const int c_ = lcnt[tid]; lbase[tid] = c_ ? (int)atomicAdd(cnt + 64 * tid, (unsigned)c_) : 0; }
              __syncthreads();
              if (tid < 128) { const size_t s_ = (size_t)2 * m0 + tid; R_EID[s_] = e_; R_WT[s_] = dec_w[tid]; R_RANK[s_] = lbase[e_] + lr_; }
              __syncthreads();
          }
      }
      SEAM(cb + 6);
      if (INC(7) || INC(8) || INC(9)) { PHASE_LOCALS;
          if (tid == 0) { const unsigned* cnt = ctl + CW_CNT + 2048 * l; int acc = 0; for (int e = 0; e < NEXP; ++e) { tstart[e] = acc; acc += (int)((__hip_atomic_load(cnt + 64 * e, __ATOMIC_RELAXED, __HIP_MEMORY_SCOPE_AGENT) + 255u) >> 8); } tstart[NEXP] = acc; }
          __syncthreads();
      }
      for (int rep_ = 0; rep_ < (INC(7) ? NREP(100 + 7) : 0); ++rep_) { PHASE_LOCALS;
          for (int s = gw; s < 2 * NTOK; s += NGW) { const int e = R_EID[s], dest = tstart[e] * 256 + R_RANK[s]; if (lane == 0) R_SLOT[s] = dest;
              const u32x4* src = (const u32x4*)(HB + (size_t)(s >> 1) * DM) + lane; u32x4* dst = (u32x4*)(XS + (size_t)dest * DM) + lane;
#pragma unroll
              for (int j = 0; j < 4; ++j) dst[64 * j] = src[64 * j]; }
      }
      SEAM(cb + 7);
      for (int rep_ = 0; rep_ < (INC(8) ? NREP(100 + 8) : 0); ++rep_) { PHASE_LOCALS; pg8::Dims g{DM, DM * 2, DM * 2, 0}; MoeOrder S{(const char*)XS, (size_t)256 * DM * 2, (const char*)W_M13, (size_t)1024 * DM * 2, (size_t)256 * DM * 2, 4, tstart[NEXP] * 4, G, bx, tstart};
          pg8::EpiSwiglu E{HM}; pg8::gemm_phase<pg8::EpiSwiglu, MoeOrder>(ldsl, g, S, E, tid); }
      SEAM(cb + 8);
      for (int rep_ = 0; rep_ < (INC(9) ? NREP(100 + 9) : 0); ++rep_) { PHASE_LOCALS; pg8::Dims g{FF, FF * 2, FF * 2, 0}; MoeOrder S{(const char*)HM, (size_t)256 * FF * 2, (const char*)W_M2, (size_t)DM * FF * 2, (size_t)256 * FF * 2, 8, tstart[NEXP] * 8, G, bx, tstart};
          pg8::EpiBf16 E{YB, DM}; pg8::gemm_phase<pg8::EpiBf16, MoeOrder>(ldsl, g, S, E, tid); }
      SEAM(cb + 9);
      for (int rep_ = 0; rep_ < (INC(10) ? NREP(100 + 10) : 0); ++rep_) { PHASE_LOCALS;
          for (int m = gw; m < NTOK; m += NGW) { const float w0 = R_WT[2 * m], w1 = R_WT[2 * m + 1]; const u32x2* y0 = (const u32x2*)(YB + (size_t)R_SLOT[2 * m] * DM) + lane; const u32x2* y1 = (const u32x2*)(YB + (size_t)R_SLOT[2 * m + 1] * DM) + lane;
              f32x4* xr = (f32x4*)(xs + (size_t)m * DM) + lane; f32x4 v[8]; float ss = 0.f;
#pragma unroll
              for (int j = 0; j < 8; ++j) { const u32x2 a = y0[64 * j], b = y1[64 * j]; f32x4 x = xr[64 * j];
                  x.x += w0 * bf2f((unsigned short)a.x) + w1 * bf2f((unsigned short)b.x); x.y += w0 * bf2f((unsigned short)(a.x >> 16)) + w1 * bf2f((unsigned short)(b.x >> 16));
                  x.z += w0 * bf2f((unsigned short)a.y) + w1 * bf2f((unsigned short)b.y); x.w += w0 * bf2f((unsigned short)(a.y >> 16)) + w1 * bf2f((unsigned short)(b.y >> 16));
                  xr[64 * j] = x; v[j] = x; ss += (x.x * x.x + x.y * x.y) + (x.z * x.z + x.w * x.w); }
              if (l == 0) { const float rstd = rsqrtf(wave_sum(ss) * (1.f / DM) + EPS); const f32x4* gr = (const f32x4*)(normg + (size_t)4 * DM) + lane; u32x2* o8 = (u32x2*)(HB + (size_t)m * DM) + lane;
#pragma unroll
                  for (int j = 0; j < 8; ++j) { const f32x4 gg = gr[64 * j]; u32x2 w; w.x = pk2(v[j].x * rstd * gg.x, v[j].y * rstd * gg.y); w.y = pk2(v[j].z * rstd * gg.z, v[j].w * rstd * gg.w); o8[64 * j] = w; } } }
          if (l == 0) moe_convert(KIN(I_MOEW1) + (size_t)NEXP * DM * FF, KIN(I_MOEW3) + (size_t)NEXP * DM * FF, KIN(I_MOEW2) + (size_t)NEXP * FF * DM, W_M13, W_M2, scr, gw, NGW, lane);
      }
      if (l == 0) SEAM(cb + 10);
    }
#undef IN
#undef INC
#undef SEAM
}

extern "C" void kernel_launch(void* const* d_in, const int* in_sizes, int n_in, void* d_out, int out_size, void* d_ws, size_t ws_size, hipStream_t stream) {
    static int grid = 0;
    if (grid == 0) {
        if (n_in != 27 || out_size != NTOK * DM || ws_size < WS_END) { fprintf(stderr, "kernel_launch: unexpected shapes (n_in %d out %d ws %zu)\n", n_in, out_size, ws_size); grid = -1; return; }
        int dev = 0, cus = 0, per_cu = 0;
        if (hipGetDevice(&dev) != hipSuccess || hipDeviceGetAttribute(&cus, hipDeviceAttributeMultiprocessorCount, dev) != hipSuccess) { grid = -1; return; }
        if (hipFuncSetAttribute((const void*)mk_fwd, hipFuncAttributeMaxDynamicSharedMemorySize, LDS_BYTES) != hipSuccess) { grid = -1; return; }
        if (hipOccupancyMaxActiveBlocksPerMultiprocessor(&per_cu, (const void*)mk_fwd, 512, LDS_BYTES) != hipSuccess || per_cu < 1) fprintf(stderr, "kernel_launch: occupancy query says %d\n", per_cu);
        (void)hipGetLastError();
        grid = cus;
    }
    if (grid < 0) return;
    (void)hipMemsetAsync((char*)d_ws + WS_CTL, 0, CTL_ZERO_BYTES, stream);
    Args a{};
    for (int i = 0; i < 27; ++i) a.in[i] = (const float*)d_in[i];
    a.out = (float*)d_out; a.ws = (unsigned char*)d_ws;
#ifndef MK_CUTS
    a.ph_lo = 0; a.ph_hi = NPHASE;
    hipLaunchKernelGGL(mk_fwd, dim3(grid), dim3(512), LDS_BYTES, stream, a);
#else
    for (int p = 0; p < NPHASE; ++p) { a.ph_lo = p; a.ph_hi = p + 1; hipLaunchKernelGGL(mk_fwd, dim3(grid), dim3(512), LDS_BYTES, stream, a); }
#endif
}
```

```cpp
#include <hip/hip_runtime.h>
#include <cstdio>
#include <cstdint>

#define LAS __attribute__((address_space(3)))
#define GAS __attribute__((address_space(1)))
typedef unsigned short bf16_t;
typedef short bf16x8 __attribute__((ext_vector_type(8)));
typedef short s16x4 __attribute__((ext_vector_type(4)));
typedef float f32x2 __attribute__((ext_vector_type(2)));
typedef float f32x4 __attribute__((ext_vector_type(4)));
typedef float f32x16 __attribute__((ext_vector_type(16)));
typedef unsigned u32x2 __attribute__((ext_vector_type(2)));
typedef unsigned u32x4 __attribute__((ext_vector_type(4)));
typedef unsigned long long u64;

#define LDS_WAIT() asm volatile("s_waitcnt lgkmcnt(0)" ::: "memory")
#define VM_WAIT() asm volatile("s_waitcnt vmcnt(0)" ::: "memory")

constexpr int NB = 4, T = 4096, NTOK = NB * T, DM = 2048, HD = 128;
constexpr float EPS = 1e-6f;
constexpr int LDZ0 = 5888, LDZ1 = 6400;
constexpr int ZQ = 0, ZKV = 1024, ZDQ = 2560, ZDK = 3584, ZDV = 4608, ZG = 5632;
constexpr int Z1Q = 0, Z1K = 2048, Z1V = 4096, Z1F = 6144;
constexpr int NEXP = 32, FF = 512, PMAX = 40960;

constexpr size_t MiB = 1u << 20;
constexpr size_t WS_CTL = 0, CTL_ZERO_BYTES = 1 * MiB;
constexpr size_t WS_ROPE = 1 * MiB, WS_MISC = 3 * MiB, WS_GATES = 4 * MiB, WS_SEL = 6 * MiB, WS_CBUF = 7 * MiB, WS_ROUTE = 8 * MiB;
constexpr size_t WS_KC = 9 * MiB, WS_VC = 9 * MiB + 512 * 1024, WS_HID = 10 * MiB, WS_CAKV = 12 * MiB, WS_MEMN = 16 * MiB;
constexpr size_t WS_W_EVIN = 24 * MiB, WS_W_EVOUT = 47 * MiB, WS_W_CMP1 = 55 * MiB, WS_W_ODIN = 59 * MiB, WS_W_ODOUT = 84 * MiB;
constexpr size_t WS_W_CAQ = 92 * MiB, WS_W_CAKV = 96 * MiB, WS_W_CAO = 104 * MiB, WS_W_RT = 108 * MiB, WS_W_M13 = 110 * MiB, WS_W_M2 = 238 * MiB;
constexpr size_t WS_HB = 302 * MiB, WS_Z = 366 * MiB, WS_XS = WS_Z, WS_ATT = 567 * MiB, WS_YB = WS_ATT;
constexpr size_t WS_OC = WS_ATT, WS_OS = WS_ATT + 32 * MiB, WS_OW = WS_ATT + 64 * MiB, WS_O1 = WS_ATT + 96 * MiB, WS_O2 = WS_ATT + 128 * MiB, WS_OMIX = WS_ATT + 160 * MiB;
constexpr size_t WS_CAQ = 791 * MiB, WS_OCA = 807 * MiB, WS_LOGITS = 823 * MiB, WS_HM = 839 * MiB, WS_SSP = 879 * MiB, WS_END = 887 * MiB;
static_assert((size_t)(NTOK + 32) * LDZ1 * 2 <= 201 * MiB && (size_t)PMAX * DM * 2 <= 201 * MiB, "z / xs region");
constexpr int CW_ERR = 0, CW_BAR = 4096, CW_CNT = 8192;

constexpr int RING_BYTES = 131072, MISC_OFF = RING_BYTES, MOE_OFF = RING_BYTES + 512, LDS_BYTES = 147456;

__device__ __forceinline__ unsigned f2bf(float f) { unsigned u = __builtin_bit_cast(unsigned, f); return (u + 0x7fffu + ((u >> 16) & 1u)) >> 16; }
__device__ __forceinline__ unsigned pk2(float lo, float hi) { return f2bf(lo) | (f2bf(hi) << 16); }
__device__ __forceinline__ float bf2f(unsigned short b) { return __builtin_bit_cast(float, (unsigned)b << 16); }
__device__ __forceinline__ unsigned cvtpk(float lo, float hi) { unsigned r; asm volatile("v_cvt_pk_bf16_f32 %0, %1, %2" : "=v"(r) : "v"(lo), "v"(hi)); return r; }
__device__ __forceinline__ int opaque(int v) { asm volatile("" : "+v"(v)); return v; }
__device__ __forceinline__ float wave_sum(float v) {
#pragma unroll
    for (int o = 1; o < 64; o <<= 1) v += __shfl_xor(v, o);
    return v;
}

#define XB_TMO      128
#define XB_XCNT(j)  (256  + 64 * (j))
#define XB_XSUB(j)  (1280 + 64 * (j))
#define XB_XGEN(j)  (2304 + 64 * (j))
#define XB_TOP      3328
#define XB_TOPGEN   3392
#define XCD_BAR_WORDS 3456
#define XB_SPIN_CAP (1u << 18)
__device__ __forceinline__ unsigned xb_ld(unsigned* p)              { return __hip_atomic_load(p, __ATOMIC_RELAXED, __HIP_MEMORY_SCOPE_AGENT); }
__device__ __forceinline__ unsigned xb_add(unsigned* p, unsigned v) { return __hip_atomic_fetch_add(p, v, __ATOMIC_RELAXED, __HIP_MEMORY_SCOPE_AGENT); }
__device__ __forceinline__ unsigned xb_xcc_id() { return (unsigned)__builtin_amdgcn_s_getreg((3 << 11) | 20) & 0xFu; }
#define XB_SPIN(cond, bar) do { unsigned _sp = 0; while (cond) { __builtin_amdgcn_s_sleep(1); \
    if ((++_sp & 255u) == 0u) { if (xb_ld(&(bar)[XB_TMO])) break; if (_sp > XB_SPIN_CAP) { atomicAdd(&(bar)[XB_TMO], 1u); break; } } } } while (0)
struct XcdBarrier { unsigned* bar; unsigned x; volatile LAS unsigned* st; };
__device__ __forceinline__ XcdBarrier xcd_barrier_post(unsigned* bar, volatile LAS unsigned* st) {
    XcdBarrier b; b.bar = bar; b.x = xb_xcc_id(); b.st = st;
    if (threadIdx.x == 0) (void)xb_add(&bar[XB_XCNT(b.x)], 1u);
    return b;
}
__device__ __forceinline__ void xcd_barrier_complete(unsigned* bar, unsigned x, unsigned& nloc, unsigned& nx) {
    const unsigned G = gridDim.x * gridDim.y * gridDim.z;
    unsigned sum, cnt, mine, sp = 0u;
    for (;;) {
        sum = 0u; cnt = 0u; mine = 0u;
#pragma unroll
        for (unsigned j = 0; j < 16; ++j) { const unsigned c = xb_ld(&bar[XB_XCNT(j)]); sum += c; cnt += (c > 0u) ? 1u : 0u; mine = (j == x) ? c : mine; }
        if (sum == G) break;
        __builtin_amdgcn_s_sleep(1);
        if ((++sp & 255u) == 0u) { if (xb_ld(&bar[XB_TMO])) break; if (sp > XB_SPIN_CAP) { atomicAdd(&bar[XB_TMO], 1u); break; } }
    }
    nloc = mine > 0u ? mine : 1u; nx = cnt > 0u ? cnt : 1u;
}
__device__ __forceinline__ void xcd_barrier(const XcdBarrier& b) {
    asm volatile("s_waitcnt vmcnt(0)" ::: "memory");
    __syncthreads();
    if (threadIdx.x == 0) {
        unsigned* bar = b.bar;
        __builtin_amdgcn_s_waitcnt(0);
        unsigned nloc = b.st[0], nx = b.st[1];
        if (nloc == 0u) { xcd_barrier_complete(bar, b.x, nloc, nx); b.st[0] = nloc; b.st[1] = nx; }
        const unsigned old = xb_add(&bar[XB_XSUB(b.x)], 1u);
        const unsigned gen = old / nloc;
        if (old + 1u == (gen + 1u) * nloc) {
            __builtin_amdgcn_fence(__ATOMIC_RELEASE, "agent");
            asm volatile("s_waitcnt vmcnt(0)" ::: "memory");
            const unsigned og = xb_add(&bar[XB_TOP], 1u);
            const unsigned tg = og / nx;
            if (og + 1u == (tg + 1u) * nx) xb_add(&bar[XB_TOPGEN], 1u);
            else XB_SPIN(xb_ld(&bar[XB_TOPGEN]) == tg, bar);
            __builtin_amdgcn_fence(__ATOMIC_ACQUIRE, "agent");
            xb_add(&bar[XB_XGEN(b.x)], 1u);
            asm volatile("s_waitcnt vmcnt(0)" ::: "memory");
        } else {
            XB_SPIN(xb_ld(&bar[XB_XGEN(b.x)]) == gen, bar);
            __builtin_amdgcn_fence(__ATOMIC_ACQUIRE, "agent");
            asm volatile("s_waitcnt vmcnt(0)" ::: "memory");
        }
    }
    __syncthreads();
}

namespace pg8 {
constexpr int BM = 256, BK = 64, HALF = 128, HTB = HALF * BK * 2, STAGE_BYTES = 8 * HTB, NXCD = 8, WGM = 8;
__host__ __device__ __forceinline__ int lds_byte(int r, int c) { const int st = (r >> 4) * 2 + (c >> 5), rr = r & 15, cc = c & 31, ob = rr * 64 + cc * 2; return st * 1024 + (ob ^ (((ob >> 9) & 1) << 5)); }
__host__ __device__ __forceinline__ void stage_rc(int b, int& R, int& C) { const int st = b / 1024, sb = b % 1024, swz = sb ^ (((sb >> 9) & 1) << 5); R = (st >> 1) * 16 + swz / 64; C = (st & 1) * 32 + (swz % 64) / 2; }
__host__ __device__ __forceinline__ int perm32(int rho) { const int n = rho >> 4, i = rho & 15; return 8 * (i >> 2) + 4 * n + (i & 3); }

struct Unit { const char* a; const char* b; int pm, pn; };
struct Dims { int K; int lda, ldb; int segstride; };

struct DenseOrder {
    const char* A; const char* Bt; size_t tA, tB;
    int nM, nN, nwg, G, c;
    __device__ void init(const void* A_, const void* Bt_, int M, int N, size_t lda, size_t ldb, int G_, int c_) { A = (const char*)A_; Bt = (const char*)Bt_; tA = 256 * lda; tB = 256 * ldb; nM = M / BM; nN = N / BM; nwg = nM * nN; G = G_; c = c_; }
    __device__ bool next(int i, Unit& u) const {
        const long L = (long)i * G + c; if (L >= nwg) return false;
        int wgid = (int)L; { const int q = nwg / NXCD, r = nwg % NXCD, xcd = wgid % NXCD, off = wgid / NXCD; wgid = (xcd < r ? xcd * (q + 1) : r * (q + 1) + (xcd - r) * q) + off; }
        const int nig = WGM * nN, gid = wgid / nig, fm = gid * WGM, gsz = (nM - fm) < WGM ? (nM - fm) : WGM;
        u.pm = fm + ((wgid % nig) % gsz); u.pn = (wgid % nig) / gsz; u.a = A + (size_t)u.pm * tA; u.b = Bt + (size_t)u.pn * tB; return true;
    }
};

template <class Epi, class Sched, bool SEG = false>
__device__ __forceinline__ void gemm_phase(LAS unsigned char* lds, const Dims g, const Sched& S, const Epi& E, const int tid) {
    const int wid = __builtin_amdgcn_readfirstlane(tid >> 6), lane = tid & 63, wr = wid >> 2, wc = wid & 3, fr = lane & 15, fq = lane >> 4;
    const int K = g.K, nt = K / BK;
    unsigned voffA[2], voffB[2];
#pragma unroll
    for (int i = 0; i < 2; ++i) { int R, C; stage_rc(tid * 16 + i * 8192, R, C); const int Rb = Epi::PERM ? ((R & ~31) + perm32(R & 31)) : R;
        voffA[i] = (unsigned)(R * g.lda + C * 2); voffB[i] = (unsigned)(Rb * g.ldb + C * 2); }
    const size_t hstepA = (size_t)HALF * g.lda, hstepB = (size_t)HALF * g.ldb;
    const unsigned ldsw = (unsigned)wid * 1024u;
    const int aoff = lds_byte(wr * 64 + fr, fq * 8), boff = lds_byte(wc * 32 + fr, fq * 8);
#define PG8_KOA(kt) (SEG ? ((size_t)((kt) >> 1) * (size_t)g.segstride + (size_t)((kt) & 1) * 128u) : (size_t)(kt) * 128u)
#define PG8_KOB(kt) ((size_t)(kt) * 128u)
#define PG8_SA(b, h) (((b) * 2 + (h)) * HTB)
#define PG8_SB(b, h) ((4 + (b) * 2 + (h)) * HTB)
#define PG8_STAGE(bufoff, gbase, voff) do { _Pragma("unroll") for (int _i = 0; _i < 2; ++_i) \
        __builtin_amdgcn_global_load_lds((const unsigned*)((const char*)(gbase) + (voff)[_i]), (LAS unsigned*)(lds + (bufoff) + ldsw + _i * 8192), 16, 0, 0); } while (0)
#define PG8_LDA(dst, b, h) do { _Pragma("unroll") for (int m = 0; m < 4; ++m) _Pragma("unroll") for (int k = 0; k < 2; ++k) dst[m][k] = *(const LAS bf16x8*)(lds + PG8_SA(b, h) + aoff + m * 2048 + k * 1024); } while (0)
#define PG8_LDB(dst, b, h) do { _Pragma("unroll") for (int n = 0; n < 2; ++n) _Pragma("unroll") for (int k = 0; k < 2; ++k) dst[n][k] = *(const LAS bf16x8*)(lds + PG8_SB(b, h) + boff + n * 2048 + k * 1024); } while (0)
#define PG8_MMA(ai, bj, At, Bt) do { __builtin_amdgcn_s_setprio(1); _Pragma("unroll") for (int m = 0; m < 4; ++m) _Pragma("unroll") for (int n = 0; n < 2; ++n) _Pragma("unroll") for (int k = 0; k < 2; ++k) \
        acc[ai][bj][m][n] = __builtin_amdgcn_mfma_f32_16x16x32_bf16(Bt[n][k], At[m][k], acc[ai][bj][m][n], 0, 0, 0); __builtin_amdgcn_s_setprio(0); } while (0)
#define PG8_WAIT_V(n) asm volatile("s_waitcnt vmcnt(" #n ")" ::: "memory")
#define PG8_WAIT_L(n) asm volatile("s_waitcnt lgkmcnt(" #n ")" ::: "memory")
#define PG8_BAR __builtin_amdgcn_s_barrier()
#define PG8_SCHED __builtin_amdgcn_sched_barrier(0)
    Unit cur, nxt; int ui = 0;
    if (!S.next(0, cur)) return;
    f32x4 acc[2][2][4][2];
#pragma unroll
    for (int a = 0; a < 2; ++a)
#pragma unroll
        for (int b = 0; b < 2; ++b)
#pragma unroll
            for (int m = 0; m < 4; ++m)
#pragma unroll
                for (int n = 0; n < 2; ++n) acc[a][b][m][n] = (f32x4){0.f, 0.f, 0.f, 0.f};
    bf16x8 At[4][2], B0[2][2], B1[2][2];
    const char* cA = cur.a; const char* cB = cur.b;
    PG8_STAGE(PG8_SB(0, 0), cB, voffB); PG8_STAGE(PG8_SB(0, 1), cB + hstepB, voffB); PG8_STAGE(PG8_SA(0, 0), cA, voffA); PG8_STAGE(PG8_SA(0, 1), cA + hstepA, voffA);
    if (wr == 1) PG8_BAR;
    PG8_WAIT_V(2); PG8_BAR;
    PG8_STAGE(PG8_SB(1, 0), cB + PG8_KOB(1), voffB); PG8_STAGE(PG8_SA(1, 0), cA + PG8_KOA(1), voffA); PG8_STAGE(PG8_SB(1, 1), cB + hstepB + PG8_KOB(1), voffB);
    PG8_WAIT_V(6); PG8_BAR;
    for (;;) {
        const bool has_next = S.next(ui + 1, nxt);
        const char* nA = has_next ? nxt.a : cA; const char* nB = has_next ? nxt.b : cB;
        for (int t = 0; t < nt; t += 2) {
            const bool last = (t == nt - 2);
            const char* a1 = cA + PG8_KOA(t + 1);
            const char* bA2 = last ? nA : cA; const char* bB2 = last ? nB : cB; const int kt2 = last ? 0 : t + 2;
            const char* a2 = bA2 + PG8_KOA(kt2); const char* b2 = bB2 + PG8_KOB(kt2);
            const char* a3 = bA2 + PG8_KOA(kt2 + 1); const char* b3 = bB2 + PG8_KOB(kt2 + 1);
            PG8_LDB(B0, 0, 0); PG8_LDB(B1, 0, 1); PG8_SCHED; PG8_LDA(At, 0, 0); PG8_STAGE(PG8_SA(1, 1), a1 + hstepA, voffA);
            PG8_WAIT_V(8); PG8_WAIT_L(0); PG8_BAR; PG8_MMA(0, 0, At, B0); PG8_MMA(0, 1, At, B1); PG8_BAR; PG8_SCHED;
            PG8_LDA(At, 0, 1); PG8_STAGE(PG8_SB(0, 0), b2, voffB); PG8_STAGE(PG8_SB(0, 1), b2 + hstepB, voffB); PG8_STAGE(PG8_SA(0, 0), a2, voffA);
            PG8_WAIT_V(8); PG8_WAIT_L(0); PG8_BAR; PG8_MMA(1, 0, At, B0); PG8_MMA(1, 1, At, B1); PG8_BAR; PG8_SCHED;
            PG8_LDB(B0, 1, 0); PG8_LDB(B1, 1, 1); PG8_SCHED; PG8_LDA(At, 1, 0); PG8_STAGE(PG8_SA(0, 1), a2 + hstepA, voffA);
            PG8_WAIT_V(8); PG8_WAIT_L(0); PG8_BAR; PG8_MMA(0, 0, At, B0); PG8_MMA(0, 1, At, B1); PG8_BAR; PG8_SCHED;
            PG8_LDA(At, 1, 1); PG8_STAGE(PG8_SB(1, 0), b3, voffB); PG8_STAGE(PG8_SB(1, 1), b3 + hstepB, voffB); PG8_STAGE(PG8_SA(1, 0), a3, voffA);
            PG8_WAIT_V(8); PG8_WAIT_L(0); PG8_BAR; PG8_MMA(1, 0, At, B0); PG8_MMA(1, 1, At, B1); PG8_BAR; PG8_SCHED;
        }
        if (wr == 0) PG8_BAR;
        E(acc, cur, wr, wc, fr, fq);
        if (!has_next) break;
#pragma unroll
        for (int a = 0; a < 2; ++a)
#pragma unroll
            for (int b = 0; b < 2; ++b)
#pragma unroll
                for (int m = 0; m < 4; ++m)
#pragma unroll
                    for (int n = 0; n < 2; ++n) acc[a][b][m][n] = (f32x4){0.f, 0.f, 0.f, 0.f};
        cur = nxt; cA = nA; cB = nB; ++ui;
        if (wr == 1) PG8_BAR;
    }
    PG8_WAIT_V(0);
    PG8_BAR;
#undef PG8_KOA
#undef PG8_KOB
#undef PG8_SA
#undef PG8_SB
#undef PG8_STAGE
#undef PG8_LDA
#undef PG8_LDB
#undef PG8_MMA
#undef PG8_WAIT_V
#undef PG8_WAIT_L
#undef PG8_BAR
#undef PG8_SCHED
}
}

namespace pg8 {
struct EpiBf16 {
    static constexpr bool PERM = true;
    bf16_t* O; int ldc;
    __device__ __forceinline__ void operator()(const f32x4 (&acc)[2][2][4][2], const Unit& u, int wr, int wc, int fr, int fq) const {
        const int row0 = u.pm * BM + wr * 64 + fr, col0 = u.pn * BM + wc * 32 + 8 * fq;
#pragma unroll
        for (int ai = 0; ai < 2; ++ai)
#pragma unroll
            for (int m = 0; m < 4; ++m) { bf16_t* rowp = O + (size_t)(row0 + ai * HALF + m * 16) * ldc + col0;
#pragma unroll
                for (int bj = 0; bj < 2; ++bj) { const f32x4 v0 = acc[ai][bj][m][0], v1 = acc[ai][bj][m][1];
                    u32x4 w; w.x = cvtpk(v0[0], v0[1]); w.y = cvtpk(v0[2], v0[3]); w.z = cvtpk(v1[0], v1[1]); w.w = cvtpk(v1[2], v1[3]);
                    *(u32x4*)(rowp + bj * HALF) = w; } }
    }
};
struct EpiF32 {
    static constexpr bool PERM = false;
    float* C; const float* R; int ldc;
    __device__ __forceinline__ void operator()(const f32x4 (&acc)[2][2][4][2], const Unit& u, int wr, int wc, int fr, int fq) const {
        const int row0 = u.pm * BM + wr * 64 + fr, col0 = u.pn * BM + wc * 32 + 4 * fq;
#pragma unroll
        for (int ai = 0; ai < 2; ++ai)
#pragma unroll
            for (int m = 0; m < 4; ++m) { const size_t ro = (size_t)(row0 + ai * HALF + m * 16) * ldc + col0;
#pragma unroll
                for (int bj = 0; bj < 2; ++bj)
#pragma unroll
                    for (int n = 0; n < 2; ++n) { f32x4 v = acc[ai][bj][m][n]; if (R) v += *(const f32x4*)(R + ro + bj * HALF + n * 16); *(f32x4*)(C + ro + bj * HALF + n * 16) = v; } }
    }
};
struct EpiGelu {
    static constexpr bool PERM = true;
    bf16_t* O; const float* bias;
    __device__ __forceinline__ void operator()(const f32x4 (&acc)[2][2][4][2], const Unit& u, int wr, int wc, int fr, int fq) const {
        const int row0 = u.pm * BM + wr * 64 + fr, col0 = wc * 32 + 8 * fq;
        bf16_t* Ob = O + (size_t)u.pn * 2048 * 256; const float* bb = bias + u.pn * 256;
#pragma unroll
        for (int ai = 0; ai < 2; ++ai)
#pragma unroll
            for (int m = 0; m < 4; ++m) { bf16_t* rowp = Ob + (size_t)(row0 + ai * HALF + m * 16) * 256 + col0;
#pragma unroll
                for (int bj = 0; bj < 2; ++bj) { float v[8];
#pragma unroll
                    for (int n = 0; n < 2; ++n) { const f32x4 bv = *(const f32x4*)(bb + col0 + bj * HALF + 4 * n);
#pragma unroll
                        for (int j = 0; j < 4; ++j) { const float x = acc[ai][bj][m][n][j] + bv[j]; const float uu = 1.5957691216f * (x + 0.044715f * x * x * x); v[4 * n + j] = x / (1.0f + __expf(-uu)); } }
                    u32x4 w; w.x = cvtpk(v[0], v[1]); w.y = cvtpk(v[2], v[3]); w.z = cvtpk(v[4], v[5]); w.w = cvtpk(v[6], v[7]);
                    *(u32x4*)(rowp + bj * HALF) = w; } }
    }
};
struct EpiResNorm {
    static constexpr bool PERM = true;
    float* C; const float* R; int ldc; bf16_t* Hn; const float* gain; float* SS;
    __device__ __forceinline__ void operator()(const f32x4 (&acc)[2][2][4][2], const Unit& u, int wr, int wc, int fr, int fq) const {
        const int row0 = u.pm * BM + wr * 64 + fr, col0 = u.pn * BM + wc * 32 + 8 * fq;
        f32x4 gv[2][2];
#pragma unroll
        for (int bj = 0; bj < 2; ++bj)
#pragma unroll
            for (int n = 0; n < 2; ++n) gv[bj][n] = *(const f32x4*)(gain + col0 + bj * HALF + 4 * n);
#pragma unroll
        for (int ai = 0; ai < 2; ++ai)
#pragma unroll
            for (int m = 0; m < 4; ++m) { const int row = row0 + ai * HALF + m * 16; const size_t ro = (size_t)row * ldc + col0; float ssq = 0.f;
#pragma unroll
                for (int bj = 0; bj < 2; ++bj) { f32x4 v0 = acc[ai][bj][m][0] + *(const f32x4*)(R + ro + bj * HALF), v1 = acc[ai][bj][m][1] + *(const f32x4*)(R + ro + bj * HALF + 4);
                    *(f32x4*)(C + ro + bj * HALF) = v0; *(f32x4*)(C + ro + bj * HALF + 4) = v1;
                    ssq += (v0[0] * v0[0] + v0[1] * v0[1]) + (v0[2] * v0[2] + v0[3] * v0[3]) + (v1[0] * v1[0] + v1[1] * v1[1]) + (v1[2] * v1[2] + v1[3] * v1[3]);
                    v0 *= gv[bj][0]; v1 *= gv[bj][1];
                    u32x4 w; w.x = cvtpk(v0[0], v0[1]); w.y = cvtpk(v0[2], v0[3]); w.z = cvtpk(v1[0], v1[1]); w.w = cvtpk(v1[2], v1[3]);
                    *(u32x4*)(Hn + ro + bj * HALF) = w; }
                ssq += __shfl_xor(ssq, 16); ssq += __shfl_xor(ssq, 32);
                if (fq == 0) SS[(size_t)row * 32 + u.pn * 4 + wc] = ssq; }
    }
};
struct EpiSwiglu {
    static constexpr bool PERM = true;
    bf16_t* O; const float* RS;
    __device__ __forceinline__ void operator()(const f32x4 (&acc)[2][2][4][2], const Unit& u, int wr, int wc, int fr, int fq) const {
        const int row0 = u.pm * BM + wr * 64 + fr, col0 = u.pn * HALF + wc * 32 + 8 * fq;
#pragma unroll
        for (int ai = 0; ai < 2; ++ai)
#pragma unroll
            for (int m = 0; m < 4; ++m) { const int row = row0 + ai * HALF + m * 16; bf16_t* rowp = O + (size_t)row * FF + col0; float v[8]; const float rs = RS[row];
#pragma unroll
                for (int n = 0; n < 2; ++n)
#pragma unroll
                    for (int j = 0; j < 4; ++j) { const float a = acc[ai][0][m][n][j] * rs, b = acc[ai][1][m][n][j] * rs; v[4 * n + j] = a / (1.0f + __expf(-a)) * b; }
                u32x4 w; w.x = cvtpk(v[0], v[1]); w.y = cvtpk(v[2], v[3]); w.z = cvtpk(v[4], v[5]); w.w = cvtpk(v[6], v[7]);
                *(u32x4*)rowp = w; }
    }
};
}

namespace att {
constexpr float SCALE = 0.08838834764831845f, THR = 8.f;
constexpr int KVBLK = 64, SHM_V = 16384, SHM_K = 16384;
constexpr int ATT_SCR = 65536, ATT_CST = 65536 + 2048, ATT_IMP = 65536 + 4096;
#define KSWZ(row, colB) ((row) * 256 + ((colB) ^ (((row) & 7) << 4)))
#define SBAR() __builtin_amdgcn_sched_barrier(0)
__device__ __forceinline__ int v_st(int k, int c) { const int kk = (k & ~0xC) | ((k & 4) << 1) | ((k & 8) >> 1); return ((kk >> 3) * 4 + (c >> 5)) * 512 + ((kk & 7) * 32 + (c & 31)) * 2; }
__device__ __forceinline__ int v_rd_base(int lane) { return ((lane & 3) << 3) | (((lane >> 2) & 3) << 6) | (((lane >> 4) & 1) << 5) | (((lane >> 5) & 1) << 8); }
constexpr int v_rd_off(int d0, int ks, int half) { return d0 * 512 + ks * 4096 + half * 2048; }
__device__ __forceinline__ int crow(int r, int hi) { return (r & 3) + 8 * (r >> 2) + 4 * hi; }
__device__ __forceinline__ void mask_tile(f32x16& p0, f32x16& p1, int dq, unsigned W) {
    const float NEG = -__builtin_inff();
#pragma unroll
    for (int r = 0; r < 16; ++r) {
        const int c = (r & 3) + 8 * (r >> 2);
        if ((unsigned)(dq - c) >= W) p0[r] = NEG;
        if ((unsigned)(dq - c - 32) >= W) p1[r] = NEG;
    }
}
__device__ __forceinline__ void partialSM(f32x16& p0, f32x16& p1, float& m_reg, float& mn, float& alpha) {
    float pmax = p0[0];
#pragma unroll
    for (int r = 1; r < 16; ++r) pmax = fmaxf(pmax, p0[r]);
#pragma unroll
    for (int r = 0; r < 16; ++r) pmax = fmaxf(pmax, p1[r]);
    { auto rr = __builtin_amdgcn_permlane32_swap(__float_as_uint(pmax), __float_as_uint(pmax), false, false);
      pmax = fmaxf(__uint_as_float(rr[0]), __uint_as_float(rr[1])); }
    constexpr float C2 = 1.4426950408889634f * SCALE;
    if (__builtin_expect(__all((pmax - m_reg) * SCALE <= THR), 1)) { mn = m_reg; alpha = 1.f; }
    else { mn = fmaxf(m_reg, pmax); alpha = __builtin_amdgcn_exp2f((m_reg - mn) * C2); m_reg = mn; }
    const float mnL = -mn * C2;
#pragma unroll
    for (int r = 0; r < 16; ++r) p0[r] = fmaf(p0[r], C2, mnL);
#pragma unroll
    for (int r = 0; r < 16; ++r) p1[r] = fmaf(p1[r], C2, mnL);
#pragma unroll
    for (int r = 0; r < 16; ++r) p0[r] = __builtin_amdgcn_exp2f(p0[r]);
}
__device__ __forceinline__ void finishSM(f32x16& p0, f32x16& p1, float alpha, float& l_reg, bf16x8& pa0, bf16x8& pa1, bf16x8& pa2, bf16x8& pa3) {
#pragma unroll
    for (int r = 0; r < 16; ++r) p1[r] = __builtin_amdgcn_exp2f(p1[r]);
    float ps = 0;
#pragma unroll
    for (int r = 0; r < 16; ++r) ps += p0[r];
#pragma unroll
    for (int r = 0; r < 16; ++r) ps += p1[r];
    { auto rr = __builtin_amdgcn_permlane32_swap(__float_as_uint(ps), __float_as_uint(ps), false, false);
      ps = __uint_as_float(rr[0]) + __uint_as_float(rr[1]); }
    l_reg = l_reg * alpha + ps;
#define PK4(P, B_, OUT) do { unsigned a0 = cvtpk(P[B_+0], P[B_+1]), a1 = cvtpk(P[B_+2], P[B_+3]);                          \
        unsigned b0 = cvtpk(P[B_+4], P[B_+5]), b1 = cvtpk(P[B_+6], P[B_+7]);                                             \
        auto r0 = __builtin_amdgcn_permlane32_swap(a0, b0, false, false); auto r1 = __builtin_amdgcn_permlane32_swap(a1, b1, false, false); \
        u32x4 w = {r0[0], r1[0], r0[1], r1[1]}; OUT = *reinterpret_cast<bf16x8*>(&w); } while (0)
    PK4(p0, 0, pa0); PK4(p0, 8, pa1); PK4(p1, 0, pa2); PK4(p1, 8, pa3);
#undef PK4
}
template <int KB>
__device__ __forceinline__ void qkt(f32x16& p0, f32x16& p1, const char* K_lds, int r32, int hi, const bf16x8* qr) {
    p0 = f32x16{}; p1 = f32x16{};
    const char* kb[4];
#pragma unroll
    for (int dd = 0; dd < 4; ++dd) kb[dd] = K_lds + KB * SHM_K + KSWZ(r32, (dd * 16 + hi * 8) * 2);
#pragma unroll
    for (int d0 = 0; d0 < 8; ++d0) { const char* a = kb[d0 & 3] + (d0 >> 2) * 128;
        bf16x8 b0 = *reinterpret_cast<const bf16x8*>(a);
        bf16x8 b1 = *reinterpret_cast<const bf16x8*>(a + 32 * 256);
        p0 = __builtin_amdgcn_mfma_f32_32x32x16_bf16(b0, qr[d0], p0, 0, 0, 0);
        p1 = __builtin_amdgcn_mfma_f32_32x32x16_bf16(b1, qr[d0], p1, 0, 0, 0); }
}
template <int VB>
__device__ __forceinline__ void pv_tile(f32x16* o, int vb0, bf16x8 pa0, bf16x8 pa1, bf16x8 pa2, bf16x8 pa3) {
#define TRRD(dst, off) asm volatile("ds_read_b64_tr_b16 %0, %1 offset:%2" : "=&v"(dst) : "v"(vb0), "i"(off) : "memory")
#define PV_D0(d0) do { s16x4 l0, l1, l2, l3, h0, h1, h2, h3; constexpr int b_ = VB * SHM_V + v_rd_off(d0, 0, 0); \
        TRRD(l0, b_); TRRD(h0, b_ + 2048); TRRD(l1, b_ + 4096); TRRD(h1, b_ + 6144); TRRD(l2, b_ + 8192); TRRD(h2, b_ + 10240); TRRD(l3, b_ + 12288); TRRD(h3, b_ + 14336); \
        asm volatile("s_waitcnt lgkmcnt(0)" ::: "memory"); SBAR();   \
        o[d0] = __builtin_amdgcn_mfma_f32_32x32x16_bf16(pa0, (bf16x8){l0[0], l0[1], l0[2], l0[3], h0[0], h0[1], h0[2], h0[3]}, o[d0], 0, 0, 0);   \
        o[d0] = __builtin_amdgcn_mfma_f32_32x32x16_bf16(pa1, (bf16x8){l1[0], l1[1], l1[2], l1[3], h1[0], h1[1], h1[2], h1[3]}, o[d0], 0, 0, 0);   \
        o[d0] = __builtin_amdgcn_mfma_f32_32x32x16_bf16(pa2, (bf16x8){l2[0], l2[1], l2[2], l2[3], h2[0], h2[1], h2[2], h2[3]}, o[d0], 0, 0, 0);   \
        o[d0] = __builtin_amdgcn_mfma_f32_32x32x16_bf16(pa3, (bf16x8){l3[0], l3[1], l3[2], l3[3], h3[0], h3[1], h3[2], h3[3]}, o[d0], 0, 0, 0); } while (0)
    PV_D0(0); PV_D0(1); PV_D0(2); PV_D0(3);
#undef PV_D0
#undef TRRD
}

enum { M_CAUSAL = 0, M_FOX = 1, M_WIN = 2, M_SLC = 3, M_NONE = 4, M_CMP = 5 };
struct AttnArgs {
    const bf16_t* Q; const bf16_t* K; const bf16_t* V; bf16_t* O;
    int ldq, ldk, ldv, ldo;
    int P0, j_lo, j_hi;
    const float* cb;
    const u64* sel;
    const float* qg;
};
__device__ __forceinline__ bf16x8 ovl_frag(int j, int ks, int hi, int r32, int d0p) {
    const int jrel = (32 * d0p + r32) - 2 * (8 * j + 2 * ks + hi);
    const unsigned e0 = (jrel == 0) ? 0x3F80u : 0u, e3 = (jrel == 0 || jrel == 1) ? 0x3F00u : 0u, e4 = (jrel == 1) ? 0x3F80u : 0u, e7 = (jrel == 1 || jrel == 2) ? 0x3F00u : 0u;
    u32x4 w = {e0 | (e0 << 16), e0 | (e3 << 16), e4 | (e4 << 16), e4 | (e7 << 16)};
    return *reinterpret_cast<bf16x8*>(&w);
}

template <int MODE>
__device__ __forceinline__ void attn_block(char* lds, const AttnArgs& a, const int tid) {
    const int wid = __builtin_amdgcn_readfirstlane(tid >> 6), lane = tid & 63, r32 = lane & 31, hi = lane >> 5;
    const int NT = a.j_hi - a.j_lo;
    char* V_lds = lds; char* K_lds = lds + 2 * SHM_V;
    float* ws = (float*)(lds + ATT_SCR) + wid * 64; float* li_l = ws; float* al_l = ws + 32;
    float* cst = (float*)(lds + ATT_CST);
    const int qrow = (MODE == M_CMP) ? (8 * wid + (r32 & 7)) : (32 * wid + r32);
    const int qcol = (MODE == M_CMP) ? ((r32 >> 3) * HD) : 0;
    const int qpos = a.P0 + qrow;
    const int qlo = a.P0 + ((MODE == M_CMP) ? 8 * wid : 32 * wid);
    bf16x8 qr[8];
    { const bf16_t* qp = a.Q + (size_t)qrow * a.ldq + qcol + hi * 8;
#pragma unroll
      for (int d0 = 0; d0 < 8; ++d0) qr[d0] = *reinterpret_cast<const bf16x8*>(qp + d0 * 16); }
    if constexpr (MODE == M_NONE) {
        float ss = 0.f;
#pragma unroll
        for (int d0 = 0; d0 < 8; ++d0)
#pragma unroll
            for (int j = 0; j < 8; ++j) { const float f = bf2f((unsigned short)qr[d0][j]); ss += f * f; }
        { auto rr = __builtin_amdgcn_permlane32_swap(__float_as_uint(ss), __float_as_uint(ss), false, false); ss = __uint_as_float(rr[0]) + __uint_as_float(rr[1]); }
        const float rstd = rsqrtf(ss * (1.0f / HD) + EPS);
#pragma unroll
        for (int d0 = 0; d0 < 8; ++d0) { const f32x4 g0 = *(const f32x4*)(a.qg + d0 * 16 + hi * 8), g1 = *(const f32x4*)(a.qg + d0 * 16 + hi * 8 + 4);
            float f[8];
#pragma unroll
            for (int j = 0; j < 8; ++j) f[j] = bf2f((unsigned short)qr[d0][j]) * rstd * (j < 4 ? g0[j] : g1[j - 4]);
            u32x4 w = {cvtpk(f[0], f[1]), cvtpk(f[2], f[3]), cvtpk(f[4], f[5]), cvtpk(f[6], f[7])}; qr[d0] = *reinterpret_cast<bf16x8*>(&w); }
    }
    float cq_s = 0.f; unsigned sel_lo = 0, sel_hi = 0;
    if constexpr (MODE == M_FOX) cq_s = a.cb[qpos] * (1.0f / SCALE);
    if constexpr (MODE == M_SLC) { const u64 s = a.sel[qpos]; sel_lo = (unsigned)s; sel_hi = (unsigned)(s >> 32); }
    const int sr = tid >> 4, sc = (tid & 15) * 8, vst0 = v_st(sr, sc), vst1 = v_st(32 + sr, sc), kws = KSWZ(sr, sc * 2);
    const int vb0 = (int)(uintptr_t)V_lds + v_rd_base(lane);
    bf16x8 st_v0, st_v1, st_k0, st_k1; float st_c = 0.f;
#define SLOAD(k0) do { st_v0 = *reinterpret_cast<const bf16x8*>(a.V + (size_t)((k0) + sr) * a.ldv + sc); st_v1 = *reinterpret_cast<const bf16x8*>(a.V + (size_t)((k0) + 32 + sr) * a.ldv + sc); \
                       st_k0 = *reinterpret_cast<const bf16x8*>(a.K + (size_t)((k0) + sr) * a.ldk + sc); st_k1 = *reinterpret_cast<const bf16x8*>(a.K + (size_t)((k0) + 32 + sr) * a.ldk + sc); \
                       if constexpr (MODE == M_FOX) { if (tid < 64) st_c = a.cb[(k0) + tid]; } } while (0)
#define SWRITE(bf) do { *(bf16x8*)(V_lds + (bf) * SHM_V + vst0) = st_v0; *(bf16x8*)(V_lds + (bf) * SHM_V + vst1) = st_v1; \
                        *(bf16x8*)(K_lds + (bf) * SHM_K + kws) = st_k0; *(bf16x8*)(K_lds + (bf) * SHM_K + kws + 32 * 256) = st_k1; \
                        if constexpr (MODE == M_FOX) { if (tid < 64) cst[(bf) * 64 + tid] = st_c * (1.0f / SCALE); } } while (0)
    float m_reg = -1e30f, l_reg = 0.f; f32x16 o[4] = {}; f32x16 oi[2] = {};
    f32x16 p0, p1; float mn, alpha; bf16x8 pa0, pa1, pa2, pa3;
#define RESC(al) do { if (__any((al) < 1.f)) { if (hi == 0) al_l[r32] = (al); asm volatile("s_waitcnt lgkmcnt(0)" ::: "memory");              \
                     _Pragma("unroll") for (int r = 0; r < 16; ++r) { const float f_ = al_l[crow(r, hi)]; _Pragma("unroll") for (int d_ = 0; d_ < 4; ++d_) o[d_][r] *= f_; \
                        if constexpr (MODE == M_CMP) { oi[0][r] *= f_; oi[1][r] *= f_; } } } } while (0)
#define STEP(t, KB) do { \
        const int jt_ = a.j_lo + (t), kb_ = jt_ * KVBLK;                                                                              \
        SBAR(); qkt<KB>(p0, p1, K_lds, r32, hi, qr);                                                                                   \
        if ((t) + 1 < NT) { SLOAD(kb_ + KVBLK); }                                                                                      \
        if constexpr (MODE == M_FOX) {                                                                                                 \
            _Pragma("unroll") for (int q_ = 0; q_ < 4; ++q_) { const f32x4 c0_ = *(const f32x4*)(cst + (KB) * 64 + 8 * q_ + 4 * hi), c1_ = *(const f32x4*)(cst + (KB) * 64 + 32 + 8 * q_ + 4 * hi); \
                _Pragma("unroll") for (int j_ = 0; j_ < 4; ++j_) { p0[4 * q_ + j_] += cq_s - c0_[j_]; p1[4 * q_ + j_] += cq_s - c1_[j_]; } } }           \
        if constexpr (MODE == M_CAUSAL || MODE == M_FOX || MODE == M_SLC) { if (kb_ + KVBLK - 1 > qlo) mask_tile(p0, p1, qpos - 4 * hi - kb_, 0x7fffffffu); } \
        if constexpr (MODE == M_WIN) { if (kb_ + KVBLK - 1 > qlo || kb_ <= qlo + 31 - 512) mask_tile(p0, p1, qpos - 4 * hi - kb_, 512u); }      \
        if constexpr (MODE == M_CMP) { mask_tile(p0, p1, ((qpos - 31) >> 4) - 4 * hi - kb_, 0x80000000u); }                            \
        if constexpr (MODE == M_SLC) { const unsigned w_ = (jt_ < 32) ? sel_lo : sel_hi; if (((w_ >> (jt_ & 31)) & 1u) == 0u) {        \
                const float NEG_ = -__builtin_inff(); _Pragma("unroll") for (int r = 0; r < 16; ++r) { p0[r] = NEG_; p1[r] = NEG_; } } } \
        partialSM(p0, p1, m_reg, mn, alpha); finishSM(p0, p1, alpha, l_reg, pa0, pa1, pa2, pa3);                                       \
        RESC(alpha); SBAR();                                                                                                           \
        pv_tile<KB>(o, vb0, pa0, pa1, pa2, pa3);                                                                                       \
        if constexpr (MODE == M_CMP) {                                                                                                 \
            oi[0] = __builtin_amdgcn_mfma_f32_32x32x16_bf16(pa0, ovl_frag(jt_, 0, hi, r32, 0), oi[0], 0, 0, 0); oi[1] = __builtin_amdgcn_mfma_f32_32x32x16_bf16(pa0, ovl_frag(jt_, 0, hi, r32, 1), oi[1], 0, 0, 0); \
            oi[0] = __builtin_amdgcn_mfma_f32_32x32x16_bf16(pa1, ovl_frag(jt_, 1, hi, r32, 0), oi[0], 0, 0, 0); oi[1] = __builtin_amdgcn_mfma_f32_32x32x16_bf16(pa1, ovl_frag(jt_, 1, hi, r32, 1), oi[1], 0, 0, 0); \
            oi[0] = __builtin_amdgcn_mfma_f32_32x32x16_bf16(pa2, ovl_frag(jt_, 2, hi, r32, 0), oi[0], 0, 0, 0); oi[1] = __builtin_amdgcn_mfma_f32_32x32x16_bf16(pa2, ovl_frag(jt_, 2, hi, r32, 1), oi[1], 0, 0, 0); \
            oi[0] = __builtin_amdgcn_mfma_f32_32x32x16_bf16(pa3, ovl_frag(jt_, 3, hi, r32, 0), oi[0], 0, 0, 0); oi[1] = __builtin_amdgcn_mfma_f32_32x32x16_bf16(pa3, ovl_frag(jt_, 3, hi, r32, 1), oi[1], 0, 0, 0); } \
        if ((t) + 1 < NT) { VM_WAIT(); SWRITE((KB) ^ 1); }                                                                             \
        __syncthreads(); } while (0)
    SLOAD(a.j_lo * KVBLK); VM_WAIT(); SWRITE(0); __syncthreads();
    int t = 0;
    for (; t + 1 < NT; t += 2) { STEP(t, 0); STEP(t + 1, 1); }
    if (NT & 1) { STEP(NT - 1, 0); }
    if (hi == 0) li_l[r32] = l_reg; asm volatile("s_waitcnt lgkmcnt(0)" ::: "memory");
    float rli[16];
#pragma unroll
    for (int r = 0; r < 16; ++r) rli[r] = __builtin_amdgcn_rcpf(fmaxf(li_l[crow(r, hi)], 1e-30f));
#pragma unroll
    for (int r = 0; r < 16; ++r) { const int orow = crow(r, hi);
        bf16_t* Ow = (MODE == M_CMP) ? a.O + (size_t)(8 * wid + (orow & 7)) * a.ldo + (orow >> 3) * HD : a.O + (size_t)(32 * wid + orow) * a.ldo;
#pragma unroll
        for (int d0 = 0; d0 < 4; ++d0) { const float v = o[d0][r] * rli[r]; const float vn = __shfl_xor(v, 1);
            if ((r32 & 1) == 0) *(unsigned*)(Ow + d0 * 32 + r32) = cvtpk(v, vn); } }
    if constexpr (MODE == M_CMP) {
        float* imp = (float*)(lds + ATT_IMP);
#pragma unroll
        for (int rr = 0; rr < 4; ++rr)
#pragma unroll
            for (int d0p = 0; d0p < 2; ++d0p) { float v = 0.f;
#pragma unroll
                for (int q = 0; q < 4; ++q) v += oi[d0p][4 * q + rr] * rli[4 * q + rr];
                imp[(8 * wid + rr + 4 * hi) * 65 + 32 * d0p + r32] = v; }
        __syncthreads();
        if (tid < 64) { const int pos = a.P0 + tid, qb = pos >> 6; const float* im = imp + tid * 65;
            u64 mask = 1ull | (1ull << qb) | (qb >= 1 ? (1ull << (qb - 1)) : 0ull);
            if (qb - 2 <= 5) { for (int j = 1; j <= qb - 2; ++j) mask |= 1ull << j; }
            else { for (int k = 0; k < 5; ++k) { int best = 1; float bv = -1.f;
                    for (int j = 1; j <= qb - 2; ++j) { const float v = im[j]; if (((mask >> j) & 1ull) == 0ull && v > bv) { bv = v; best = j; } }
                    mask |= 1ull << best; } }
            ((u64*)a.sel)[pos] = mask; }
    }
    __syncthreads();
#undef STEP
#undef RESC
#undef SLOAD
#undef SWRITE
}
}

struct TrItem { const float* src; bf16_t* dst; int src_ld, dst_ld, nvalid; };
__device__ __forceinline__ void tr_load(f32x4 (&r)[8], const TrItem t, int lane) {
    const int c4 = (lane & 7) * 4, rr = lane >> 3; const float* p = t.src + (size_t)rr * t.src_ld + c4; const bool ok = c4 < t.nvalid;
#pragma unroll
    for (int i = 0; i < 8; ++i) r[i] = ok ? *(const f32x4*)(p + (size_t)(8 * i) * t.src_ld) : (f32x4){0.f, 0.f, 0.f, 0.f};
}
__device__ __forceinline__ void tr_store(const f32x4 (&r)[8], const TrItem t, LAS float* scr, int lane) {
    const int c4 = (lane & 7) * 4, rr = lane >> 3;
#pragma unroll
    for (int i = 0; i < 8; ++i) { LAS float* q = scr + (rr + 8 * i) * 33 + c4; q[0] = r[i].x; q[1] = r[i].y; q[2] = r[i].z; q[3] = r[i].w; }
    LDS_WAIT(); asm volatile("" ::: "memory");
    const int c = lane & 7;
#pragma unroll
    for (int j = 0; j < 4; ++j) { const int n = (lane >> 3) + 8 * j; const LAS float* s = scr + (8 * c) * 33 + n;
        u32x4 o; o.x = pk2(s[0 * 33], s[1 * 33]); o.y = pk2(s[2 * 33], s[3 * 33]); o.z = pk2(s[4 * 33], s[5 * 33]); o.w = pk2(s[6 * 33], s[7 * 33]);
        if (n < t.nvalid) *(u32x4*)(t.dst + (size_t)n * t.dst_ld + 8 * c) = o; }
    LDS_WAIT(); asm volatile("" ::: "memory");
}
template <class Dec>
__device__ __forceinline__ void tr_run(const Dec& D, int items, LAS float* scr, int gw, int NGW, int lane) {
    int it = gw; if (it >= items) return;
    f32x4 ra[8], rb[8];
    tr_load(ra, D(it), lane);
    for (;;) { const int nx = it + NGW; const bool hn = nx < items;
        if (hn) tr_load(rb, D(nx), lane);
        tr_store(ra, D(it), scr, lane);
        if (!hn) break;
        it = nx;
#pragma unroll
        for (int i = 0; i < 8; ++i) ra[i] = rb[i]; }
}
struct BlockDec { const float* W; bf16_t* WT; int src_ld, K, c0, ncols, drow0, nblk;
    __device__ __forceinline__ TrItem operator()(int it) const { TrItem t; const int kb = it / nblk, nb = it - kb * nblk, rem = ncols - 32 * nb;
        t.src = W + (size_t)(64 * kb) * src_ld + c0 + 32 * nb; t.dst = WT + (size_t)(drow0 + 32 * nb) * K + 64 * kb; t.src_ld = src_ld; t.dst_ld = K; t.nvalid = rem < 32 ? rem : 32; return t; } };
__device__ __forceinline__ void tr_block(const float* W, int src_ld, int K, int c0, int ncols, bf16_t* WT, int drow0, LAS float* scr, int gw, int NGW, int lane) {
    const int nblk = (ncols + 31) >> 5; BlockDec D{W, WT, src_ld, K, c0, ncols, drow0, nblk}; tr_run(D, (K >> 6) * nblk, scr, gw, NGW, lane);
}
__device__ __forceinline__ void zero_fill16(void* p, size_t bytes, int gtid, int NGT) {
    u32x4* q = (u32x4*)p; const size_t n = bytes >> 4; const u32x4 z = {0u, 0u, 0u, 0u};
    for (size_t i = gtid; i < n; i += NGT) q[i] = z;
}
struct Moe13Dec { const float* w1; const float* w3; bf16_t* W13;
    __device__ __forceinline__ TrItem operator()(int it) const { TrItem t; const int nb = it & 15, kb = (it >> 4) & 31, which = (it >> 9) & 1, e = it >> 10, c0 = nb * 32;
        t.src = (const float*)((uintptr_t)w1 + (uintptr_t)which * ((uintptr_t)w3 - (uintptr_t)w1)) + (size_t)e * DM * FF + (size_t)(64 * kb) * FF + c0; t.dst = W13 + (size_t)e * 1024 * DM + (size_t)((c0 >> 7) * 256 + which * 128 + (c0 & 127)) * DM + 64 * kb;
        t.src_ld = FF; t.dst_ld = DM; t.nvalid = 32; return t; } };
struct Moe2Dec { const float* w2; bf16_t* W2;
    __device__ __forceinline__ TrItem operator()(int it) const { TrItem t; const int nb = it & 63, kb = (it >> 6) & 7, e = it >> 9;
        t.src = w2 + (size_t)e * FF * DM + (size_t)(64 * kb) * DM + nb * 32; t.dst = W2 + (size_t)e * DM * FF + (size_t)(nb * 32) * FF + 64 * kb; t.src_ld = DM; t.dst_ld = FF; t.nvalid = 32; return t; } };
__device__ __forceinline__ void moe_convert(const float* w1, const float* w3, const float* w2, bf16_t* W13, bf16_t* W2, LAS float* scr, int gw, int NGW, int lane) {
    { Moe13Dec D{w1, w3, W13}; tr_run(D, 32768, scr, gw, NGW, lane); }
    { Moe2Dec D{w2, W2}; tr_run(D, 16384, scr, gw, NGW, lane); }
}
__device__ __forceinline__ void norm_row(const float* xrow, const float* g, bf16_t* orow, int lane) {
    const f32x4* xr = (const f32x4*)xrow + lane; const f32x4* gr = (const f32x4*)g + lane;
    f32x4 v[8]; float s = 0.f;
#pragma unroll
    for (int j = 0; j < 8; ++j) { v[j] = xr[64 * j]; s += (v[j].x * v[j].x + v[j].y * v[j].y) + (v[j].z * v[j].z + v[j].w * v[j].w); }
    const float rstd = rsqrtf(wave_sum(s) * (1.f / DM) + EPS);
    u32x2* o8 = (u32x2*)orow + lane;
#pragma unroll
    for (int j = 0; j < 8; ++j) { const f32x4 gg = gr[64 * j]; u32x2 w; w.x = pk2(v[j].x * rstd * gg.x, v[j].y * rstd * gg.y); w.y = pk2(v[j].z * rstd * gg.z, v[j].w * rstd * gg.w); o8[64 * j] = w; }
}
template <bool ROPE>
__device__ __forceinline__ void group_norm4(bf16_t* p, const float* g, int nact, const f32x2* rope_row, int lane) {
    const int c = lane & 15; const u32x4 raw = *(const u32x4*)(p + 8 * lane);
    float x[8]; x[0] = bf2f((unsigned short)raw.x); x[1] = bf2f((unsigned short)(raw.x >> 16)); x[2] = bf2f((unsigned short)raw.y); x[3] = bf2f((unsigned short)(raw.y >> 16));
    x[4] = bf2f((unsigned short)raw.z); x[5] = bf2f((unsigned short)(raw.z >> 16)); x[6] = bf2f((unsigned short)raw.w); x[7] = bf2f((unsigned short)(raw.w >> 16));
    float ss = 0.f;
#pragma unroll
    for (int j = 0; j < 8; ++j) ss += x[j] * x[j];
    ss += __shfl_xor(ss, 1); ss += __shfl_xor(ss, 2); ss += __shfl_xor(ss, 4); ss += __shfl_xor(ss, 8);
    const float rstd = rsqrtf(ss * (1.f / HD) + EPS);
    const f32x4 g0 = *(const f32x4*)(g + 8 * c), g1 = *(const f32x4*)(g + 8 * c + 4);
    float y[8];
#pragma unroll
    for (int j = 0; j < 8; ++j) y[j] = x[j] * rstd * (j < 4 ? g0[j] : g1[j - 4]);
    if constexpr (ROPE) {
        const f32x4* rp = (const f32x4*)(rope_row + 8 * (c & 7)); const float sgn = (c < 8) ? -1.f : 1.f;
#pragma unroll
        for (int q = 0; q < 4; ++q) { const f32x4 cs = rp[q];
            const float pa = __shfl_xor(y[2 * q], 8), pb = __shfl_xor(y[2 * q + 1], 8);
            y[2 * q] = y[2 * q] * cs.x + sgn * pa * cs.y; y[2 * q + 1] = y[2 * q + 1] * cs.z + sgn * pb * cs.w; }
    }
    if ((lane >> 4) < nact) { u32x4 w = {cvtpk(y[0], y[1]), cvtpk(y[2], y[3]), cvtpk(y[4], y[5]), cvtpk(y[6], y[7])}; *(u32x4*)(p + 8 * lane) = w; }
}

struct P0Dec { const float *ev_in, *ev_out, *cmpw1, *od_in, *od_out, *cawq, *cawkv, *cawo, *we, *wg; unsigned char* ws;
    static constexpr int NITEMS = 2560 + 3072 + 32 + 2048 + 1024 + 6176 + 2048 + 1024 + 2048 + 1024 + 64 + 64;
    __device__ __forceinline__ TrItem operator()(int it) const { int r = it;
#define P0_JOB(W_, sld_, K_, c0_, nc_, WT_, dr_) { constexpr int nblk_ = ((nc_) + 31) >> 5, n_ = ((K_) >> 6) * nblk_; if (r < n_) { BlockDec D{W_, (bf16_t*)(WT_), sld_, K_, c0_, nc_, dr_, nblk_}; return D(r); } r -= n_; }
        P0_JOB(ev_in, 5656, DM, 0, 2560, ws + WS_W_EVIN, 0)
        P0_JOB(ev_in, 5656, DM, 2584, 3072, ws + WS_W_EVIN, 2560)
        P0_JOB(ev_in, 5656, DM, 2560, 24, ws + WS_W_EVIN, 5632)
        P0_JOB(ev_out, DM, DM, 0, DM, ws + WS_W_EVOUT, 0)
        P0_JOB(cmpw1, 256, 4096, 0, 256, ws + WS_W_CMP1, 0)
        P0_JOB(cmpw1 + (size_t)4096 * 256, 256, 4096, 0, 256, ws + WS_W_CMP1 + (size_t)256 * 4096 * 2, 0)
        P0_JOB(od_in, 6160, DM, 0, 6160, ws + WS_W_ODIN, 0)
        P0_JOB(od_out, DM, DM, 0, DM, ws + WS_W_ODOUT, 0)
        P0_JOB(cawq, 512, DM, 0, 512, ws + WS_W_CAQ, 0)
        P0_JOB(cawq + (size_t)DM * 512, 512, DM, 0, 512, ws + WS_W_CAQ + (size_t)512 * DM * 2, 0)
        P0_JOB(cawkv, 1024, DM, 0, 1024, ws + WS_W_CAKV, 0)
        P0_JOB(cawkv + (size_t)DM * 1024, 1024, DM, 0, 1024, ws + WS_W_CAKV + (size_t)1024 * DM * 2, 0)
        P0_JOB(cawo, DM, 512, 0, DM, ws + WS_W_CAO, 0)
        P0_JOB(cawo + (size_t)512 * DM, DM, 512, 0, DM, ws + WS_W_CAO + (size_t)DM * 512 * 2, 0)
        P0_JOB(we, 32, DM, 0, 32, ws + WS_W_RT, 0)
        P0_JOB(we + (size_t)DM * 32, 32, DM, 0, 32, ws + WS_W_RT + (size_t)256 * DM * 2, 0)
        P0_JOB(wg, 4, DM, 0, 4, ws + WS_W_RT, 32)
        { constexpr int nblk_ = 1; BlockDec D{wg + (size_t)DM * 4, (bf16_t*)(ws + WS_W_RT + (size_t)256 * DM * 2), 4, DM, 0, 4, 32, nblk_}; return D(r); }
#undef P0_JOB
    } };

__device__ __forceinline__ int deal(int i, int G, int c) { return (i & 1) ? i * G + (G - 1 - c) : i * G + c; }

struct MoeOrder {
    const char* A; size_t tA; const char* Bt; size_t eB, tB; int nN, total, G, c; const LAS int* tstart;
    __device__ bool next(int i, pg8::Unit& u) const {
        const int L = i * G + c; if (L >= total) return false;
        const int rt = L / nN, pn = L - rt * nN; int e = 0;
        for (int k = 1; k < NEXP; ++k) e += (tstart[k] <= rt) ? 1 : 0;
        u.a = A + (size_t)rt * tA; u.b = Bt + (size_t)e * eB + (size_t)pn * tB; u.pm = rt; u.pn = pn; return true;
    }
};
struct CaKvOrder {
    const char* A; const char* Bt; int c;
    __device__ bool next(int i, pg8::Unit& u) const {
        if (i > 0 || c >= 32) return false;
        const int ll = c >> 4, pm = (c >> 2) & 3, pn = c & 3;
        u.a = A + ((size_t)ll * 1024 + 256 * pm) * DM * 2; u.b = Bt + ((size_t)ll * 1024 + 256 * pn) * DM * 2; u.pm = ll * 4 + pm; u.pn = pn; return true;
    }
};
struct CmpOrder {
    const char* Z; const char* Bt; int c;
    __device__ bool next(int i, pg8::Unit& u) const {
        if (i > 0 || c >= 64) return false;
        const int ks = c >> 4, kv = (c >> 3) & 1, bg = c & 7, b = bg >> 1, g = bg & 1;
        u.a = Z + ((size_t)(b * T + 8 * ks) * LDZ0 + ZKV + (kv * 2 + g) * HD) * 2; u.b = Bt + ((size_t)kv * 256 * 4096 + 1024 * ks) * 2; u.pm = c; u.pn = 0; return true;
    }
};

#ifndef ROUTE_TAU
#define ROUTE_TAU 0.02f
#endif
__device__ __forceinline__ float row_rstd(const float* ssp) {
    const f32x4* p = (const f32x4*)ssp; f32x4 a = p[0];
#pragma unroll
    for (int i = 1; i < 8; ++i) a += p[i];
    return rsqrtf(((a.x + a.y) + (a.z + a.w)) * (1.f / DM) + EPS);
}
struct RouteDec { int grp, j0, j1; float w0, w1, margin; };
__device__ __forceinline__ RouteDec route_decide(const float* lg, const float* bg, const float* be, const float rs) {
    RouteDec d; float gmax = -3.0e38f, g2 = -3.0e38f; int grp = 0;
    const float gl0 = lg[32] * rs + bg[0], gl1 = lg[33] * rs + bg[1], gl2 = lg[34] * rs + bg[2], gl3 = lg[35] * rs + bg[3];
#define RD_G(v, j) { const bool a_ = (v) > gmax, b_ = (v) > g2; g2 = a_ ? gmax : (b_ ? (v) : g2); grp = a_ ? (j) : grp; gmax = a_ ? (v) : gmax; }
    RD_G(gl0, 0) RD_G(gl1, 1) RD_G(gl2, 2) RD_G(gl3, 3)
#undef RD_G
    const float gsum = __expf(gl0 - gmax) + __expf(gl1 - gmax) + __expf(gl2 - gmax) + __expf(gl3 - gmax);
    const float ptop = 1.f / gsum;
    float v0 = -3.0e38f, v1 = -3.0e38f, v2 = -3.0e38f; int j0 = 0, j1 = 0;
#pragma unroll
    for (int j = 0; j < 8; ++j) { const float v = lg[grp * 8 + j] * rs + be[grp * 8 + j];
        const bool a_ = v > v0, b_ = v > v1, c_ = v > v2;
        v2 = b_ ? v1 : (c_ ? v : v2); j1 = a_ ? j0 : (b_ ? j : j1); v1 = a_ ? v0 : (b_ ? v : v1); j0 = a_ ? j : j0; v0 = a_ ? v : v0; }
    const float e1 = __expf(v1 - v0); d.w0 = ptop / (1.f + e1); d.w1 = ptop * e1 / (1.f + e1);
    d.margin = fminf(gmax - g2, v1 - v2); d.grp = grp; d.j0 = j0; d.j1 = j1; return d;
}
struct Args { const float* in[27]; float* out; unsigned char* ws; int ph_lo, ph_hi; };
enum { I_X = 0, I_MEM, I_NORMG, I_EVIN, I_EVOUT, I_NSAG, I_CMPPE, I_CMPW1, I_CMPW2, I_DIFFG, I_DIFFLAM, I_DIFFSUB, I_ODIN, I_ODOUT, I_FOXB, I_FOXG,
       I_CAWQ, I_CAWKV, I_CAG, I_CAWO, I_MOEWG, I_MOEBG, I_MOEWE, I_MOEBE, I_MOEW1, I_MOEW3, I_MOEW2 };
constexpr int NPHASE = 34;

__device__ __forceinline__ const void* karg_ptr(int byte_off) {
    const __attribute__((address_space(4))) char* kp = (const __attribute__((address_space(4))) char*)__builtin_amdgcn_kernarg_segment_ptr();
    return *(const void* const volatile __attribute__((address_space(4)))*)(kp + byte_off);
}
__device__ __forceinline__ int karg_int(int byte_off) {
    const __attribute__((address_space(4))) char* kp = (const __attribute__((address_space(4))) char*)__builtin_amdgcn_kernarg_segment_ptr();
    return *(const volatile int __attribute__((address_space(4)))*)(kp + byte_off);
}
#define KIN(i) ((const float*)karg_ptr(8 * (i)))
#define PHASE_LOCALS \
    unsigned char* const ws = (unsigned char*)karg_ptr(224); float* const xs = (float*)karg_ptr(216); (void)xs; \
    const int tid = opaque((int)threadIdx.x), lane = tid & 63, wave = __builtin_amdgcn_readfirstlane(tid >> 6); (void)lane; (void)wave; \
    const int G = gridDim.x, bx = blockIdx.x; const int gw = bx * 8 + wave, NGW = G * 8, gtid = bx * 512 + tid, NGT = G * 512; (void)gw; (void)NGW; (void)gtid; (void)NGT; \
    LAS float* const scr = (LAS float*)(ldsl + wave * 16384); (void)scr; LAS int* const tstart = (LAS int*)(ldsl + MOE_OFF); (void)tstart; \
    unsigned* const ctl = (unsigned*)(ws + WS_CTL); (void)ctl
#define x_in KIN(I_X)
#define normg KIN(I_NORMG)
#define HB ((bf16_t*)(ws + WS_HB))
#define Z ((bf16_t*)(ws + WS_Z))
#define ROPE ((const f32x2*)(ws + WS_ROPE))
#define CMPPART ((float*)(ws + WS_MISC))
#define CMPBIAS ((float*)(ws + WS_MISC + 65536))
#define GATES ((float*)(ws + WS_GATES))
#define SEL ((u64*)(ws + WS_SEL))
#define CBUF ((float*)(ws + WS_CBUF))
#define R_EID ((int*)(ws + WS_ROUTE))
#define R_WT ((float*)(ws + WS_ROUTE + 131072))
#define R_RANK ((int*)(ws + WS_ROUTE + 262144))
#define R_SLOT ((int*)(ws + WS_ROUTE + 393216))
#define R_RS ((float*)(ws + WS_ROUTE + 524288))
#define SSA ((float*)(ws + WS_SSP) + (size_t)(l * 2) * NTOK * 32)
#define SSB ((float*)(ws + WS_SSP) + (size_t)(l * 2 + 1) * NTOK * 32)
#define KC ((bf16_t*)(ws + WS_KC))
#define VC ((bf16_t*)(ws + WS_VC))
#define HID ((bf16_t*)(ws + WS_HID))
#define CAKV ((bf16_t*)(ws + WS_CAKV))
#define MEMN ((bf16_t*)(ws + WS_MEMN))
#define W_EVIN ((bf16_t*)(ws + WS_W_EVIN))
#define W_EVOUT ((bf16_t*)(ws + WS_W_EVOUT))
#define W_CMP1 ((bf16_t*)(ws + WS_W_CMP1))
#define W_ODIN ((bf16_t*)(ws + WS_W_ODIN))
#define W_ODOUT ((bf16_t*)(ws + WS_W_ODOUT))
#define W_CAQ ((bf16_t*)(ws + WS_W_CAQ))
#define W_CAKV ((bf16_t*)(ws + WS_W_CAKV))
#define W_CAO ((bf16_t*)(ws + WS_W_CAO))
#define W_RT ((bf16_t*)(ws + WS_W_RT))
#define W_M13 ((bf16_t*)(ws + WS_W_M13))
#define W_M2 ((bf16_t*)(ws + WS_W_M2))
#define OC ((bf16_t*)(ws + WS_OC))
#define OS ((bf16_t*)(ws + WS_OS))
#define OW ((bf16_t*)(ws + WS_OW))
#define O1 ((bf16_t*)(ws + WS_O1))
#define O2 ((bf16_t*)(ws + WS_O2))
#define OMIX ((bf16_t*)(ws + WS_OMIX))
#define CAQ ((bf16_t*)(ws + WS_CAQ))
#define OCA ((bf16_t*)(ws + WS_OCA))
#define LOGITS ((float*)(ws + WS_LOGITS))
#define XS ((bf16_t*)(ws + WS_XS))
#define HM ((bf16_t*)(ws + WS_HM))
#define YB ((bf16_t*)(ws + WS_YB))

__global__ void __launch_bounds__(512, 2) mk_fwd(Args args) {
    extern __shared__ __attribute__((aligned(16))) unsigned char lds[];
    LAS unsigned char* const ldsl = (LAS unsigned char*)lds;
    { const int t0 = threadIdx.x;
      for (int u = t0; u < (LDS_BYTES - MISC_OFF) / 4; u += 512) ((LAS unsigned*)(ldsl + MISC_OFF))[u] = 0u;
      __syncthreads();
      (void)xcd_barrier_post((unsigned*)((unsigned char*)karg_ptr(224) + WS_CTL) + CW_BAR, (volatile LAS unsigned*)(ldsl + MISC_OFF + 32)); }
    const int lo = karg_int(232), hi = karg_int(236);
#ifndef ONLY
#define ONLY (-1)
#endif
#ifndef REPEAT
#define REPEAT (-1)
#endif
#define NREP(k) ((REPEAT == (k)) ? 2 : 1)
#define PHM(k) (ONLY < 0 || ONLY == (k))
#define IN(k) (PHM(k) && lo <= (k) && (k) < hi)
#define INC(j) (PHM(100 + (j)) && lo <= (cb + (j)) && (cb + (j)) < hi)
#define SEAM(k) do { if (lo <= (k) && (k) + 1 < hi) { XcdBarrier b_; b_.bar = (unsigned*)((unsigned char*)karg_ptr(224) + WS_CTL) + CW_BAR; b_.x = xb_xcc_id(); b_.st = (volatile LAS unsigned*)(ldsl + MISC_OFF + 32); xcd_barrier(b_); } } while (0)

    for (int l = 0; l < 2; ++l) {
      if (l == 0) {
        for (int rep_ = 0; rep_ < (IN(0) ? NREP(0) : 0); ++rep_) { PHASE_LOCALS;
            { P0Dec D{KIN(I_EVIN), KIN(I_EVOUT), KIN(I_CMPW1), KIN(I_ODIN), KIN(I_ODOUT), KIN(I_CAWQ), KIN(I_CAWKV), KIN(I_CAWO), KIN(I_MOEWE), KIN(I_MOEWG), ws};
              tr_run(D, P0Dec::NITEMS, scr, gw, NGW, lane); }
            zero_fill16(W_EVIN + (size_t)5656 * DM, (size_t)(LDZ0 - 5656) * DM * 2, gtid, NGT);
            zero_fill16(W_ODIN + (size_t)6160 * DM, (size_t)(LDZ1 - 6160) * DM * 2, gtid, NGT);
            for (int ll = 0; ll < 2; ++ll) zero_fill16(W_RT + (size_t)ll * 256 * DM + (size_t)36 * DM, (size_t)220 * DM * 2, gtid, NGT);
            for (int i = gtid; i < T * 64; i += NGT) { const int pos = i >> 6, k = i & 63;
                const float inv = exp2f(-(float)k * (13.287712379549449f / 64.0f)); const float ang = (float)pos * inv;
                const double a = (double)ang, kk = rint(a * 0.15915494309189535); const float r = (float)(a - kk * 6.283185307179586);
                f32x2 cs; cs.x = __cosf(r); cs.y = __sinf(r); ((f32x2*)(ws + WS_ROPE))[i] = cs; }
            for (int tsk = gw; tsk < 256; tsk += NGW) { const int cblk = tsk & 3, chunk = (tsk >> 2) & 31, kv = tsk >> 7; const int c = cblk * 64 + lane;
                const float* pe = KIN(I_CMPPE) + (size_t)kv * 4096 + chunk * 128; const float* w = KIN(I_CMPW1) + (size_t)kv * 4096 * 256 + (size_t)chunk * 128 * 256 + c;
                float s = 0.f;
#pragma unroll 8
                for (int k = 0; k < 128; ++k) s += pe[k] * w[(size_t)k * 256];
                CMPPART[(kv * 32 + chunk) * 256 + c] = s; }
            for (int m = gw; m < NTOK; m += NGW) norm_row(x_in + (size_t)m * DM, normg + 0 * DM, HB + (size_t)m * DM, lane);
            for (int m = gw; m < 2048; m += NGW) { const int ll = m >> 10, r = m & 1023; norm_row(KIN(I_MEM) + (size_t)r * DM, normg + (size_t)(ll * 4 + 2) * DM, MEMN + (size_t)m * DM, lane); }
        }
        SEAM(0);
        for (int rep_ = 0; rep_ < (IN(1) ? NREP(1) : 0); ++rep_) { PHASE_LOCALS;
            if (bx == 0) { const int kv = tid >> 8, c = tid & 255; float s = 0.f; for (int ch = 0; ch < 32; ++ch) s += CMPPART[(kv * 32 + ch) * 256 + c]; CMPBIAS[kv * 256 + c] = s; }
            { pg8::Dims g{DM, DM * 2, DM * 2, 0}; pg8::DenseOrder S; S.init(HB, W_EVIN, NTOK, LDZ0, DM * 2, DM * 2, G, bx); pg8::EpiBf16 E{Z, LDZ0};
              pg8::gemm_phase<pg8::EpiBf16, pg8::DenseOrder>(ldsl, g, S, E, tid); }
            { pg8::Dims g{DM, DM * 2, DM * 2, 0}; CaKvOrder S{(const char*)MEMN, (const char*)W_CAKV, (bx + 64) & 255}; pg8::EpiBf16 E{CAKV, 1024};
              pg8::gemm_phase<pg8::EpiBf16, CaKvOrder>(ldsl, g, S, E, tid); }
        }
        SEAM(1);
        for (int rep_ = 0; rep_ < (IN(2) ? NREP(2) : 0); ++rep_) { PHASE_LOCALS;
            { pg8::Dims g{1024, 16 * LDZ0 * 2, 4096 * 2, LDZ0 * 2}; CmpOrder S{(const char*)Z, (const char*)W_CMP1, bx}; pg8::EpiF32 E{(float*)(ws + WS_LOGITS), nullptr, 256};
              pg8::gemm_phase<pg8::EpiF32, CmpOrder, true>(ldsl, g, S, E, tid); }
            const float* nsag = KIN(I_NSAG); const float* dg = KIN(I_DIFFG);
            const int gw2 = (G > 128) ? (bx - 64) * 8 + wave : gw, NGW2 = (G > 128) ? (G - 64) * 8 : NGW;
            for (int m = (gw2 < 0 ? NTOK : gw2); m < NTOK; m += NGW2) { bf16_t* zr = Z + (size_t)m * LDZ0; const f32x2* rr = ROPE + (size_t)(m & (T - 1)) * 64;
                group_norm4<true>(zr + ZQ, nsag, 4, rr, lane); group_norm4<true>(zr + ZQ + 512, nsag, 4, rr, lane);
                group_norm4<true>(zr + ZKV + 4 * HD, nsag + 2 * HD, 2, rr, lane); group_norm4<true>(zr + ZKV + 8 * HD, nsag + 3 * HD, 2, rr, lane);
                group_norm4<true>(zr + ZDQ, dg, 4, rr, lane); group_norm4<true>(zr + ZDQ + 512, dg, 4, rr, lane);
                group_norm4<true>(zr + ZDK, dg + HD, 4, rr, lane); group_norm4<true>(zr + ZDK + 512, dg + HD, 4, rr, lane);
                if (lane < 24) GATES[(size_t)m * 24 + lane] = 1.f / (1.f + __expf(-bf2f(zr[ZG + lane]))); }
            for (int row = gw; row < 2048; row += NGW) { const int ll = row >> 10; group_norm4<false>(CAKV + (size_t)row * 1024, KIN(I_CAG) + (ll * 2 + 1) * HD, 4, nullptr, lane); }
        }
        SEAM(2);
        for (int rep_ = 0; rep_ < (IN(3) ? NREP(3) : 0); ++rep_) { PHASE_LOCALS;
            for (int m = gw; m < 2 * 2048; m += NGW) { const int kv = m >> 11, row = m & 2047, bg = row >> 8, n = row & 255;
                bf16_t* dst = (kv ? VC : KC) + (size_t)row * HD;
                if (n == 255) { dst[lane] = 0; dst[64 + lane] = 0; continue; }
                const float* w2 = KIN(I_CMPW2) + (size_t)kv * 256 * HD; const float* slab = (const float*)(ws + WS_LOGITS) + ((size_t)(kv * 8 + bg) * 256 + n) * 256 + 4 * lane;
                f32x4 hs = *(const f32x4*)(CMPBIAS + kv * 256 + 4 * lane);
#pragma unroll
                for (int ks = 0; ks < 4; ++ks) hs += *(const f32x4*)(slab + (size_t)ks * 16 * 256 * 256);
                float hv[4];
#pragma unroll
                for (int j = 0; j < 4; ++j) { const float xx = hs[j]; const float uu = 1.5957691216f * (xx + 0.044715f * xx * xx * xx); hv[j] = bf2f((unsigned short)f2bf(xx / (1.0f + __expf(-uu)))); }
                float a0 = 0.f, a1 = 0.f;
                for (int j4 = 0; j4 < 64; ++j4) {
#pragma unroll
                    for (int jj = 0; jj < 4; ++jj) { const float hj = __shfl(hv[jj], j4); const float* wr_ = w2 + (size_t)(4 * j4 + jj) * HD; a0 += hj * wr_[lane]; a1 += hj * wr_[64 + lane]; } }
                if (kv == 0) { const float rstd = rsqrtf(wave_sum(a0 * a0 + a1 * a1) * (1.f / HD) + EPS); const float* gk = KIN(I_NSAG) + HD;
                    const float y0 = a0 * rstd * gk[lane], y1 = a1 * rstd * gk[64 + lane]; const f32x2 cs = ROPE[(size_t)(16 * n + 31) * 64 + lane];
                    a0 = y0 * cs.x - y1 * cs.y; a1 = y1 * cs.x + y0 * cs.y; }
                dst[lane] = (bf16_t)f2bf(a0); dst[64 + lane] = (bf16_t)f2bf(a1); (void)bg; }
        }
        SEAM(3);
        for (int rep_ = 0; rep_ < (IN(4) ? NREP(4) : 0); ++rep_) { PHASE_LOCALS; const int tq = tid;
            for (int i = 0;; ++i) { const int idx = deal(i, G, bx); if (idx >= 512) break;
                const int tb = 63 - (idx >> 3), rest = idx & 7, b = rest >> 1, g2 = rest & 1, P0 = 64 * tb;
                att::AttnArgs a; a.Q = Z + (size_t)(b * T + P0) * LDZ0 + ZQ + g2 * 4 * HD; a.ldq = LDZ0; a.K = KC + (size_t)(b * 2 + g2) * 256 * HD; a.V = VC + (size_t)(b * 2 + g2) * 256 * HD; a.ldk = HD; a.ldv = HD;
                a.O = OC + (size_t)(b * T + P0) * 1024 + g2 * 4 * HD; a.ldo = 1024; a.P0 = P0; a.j_lo = 0; a.j_hi = (((P0 + 32) >> 4) >> 6) + 1; a.cb = nullptr; a.sel = SEL + (size_t)(b * 2 + g2) * T; a.qg = nullptr;
                att::attn_block<att::M_CMP>((char*)lds, a, tq); }
        }
        SEAM(4);
        for (int rep_ = 0; rep_ < (IN(5) ? NREP(5) : 0); ++rep_) { PHASE_LOCALS; const int tq = tid;
            bool conv = false;
            for (int i = 0;; ++i) { const int idx = deal(i, G, bx);
                if (!conv && (i == (bx & 7) || idx >= 2048)) { conv = true; moe_convert(KIN(I_MOEW1), KIN(I_MOEW3), KIN(I_MOEW2), W_M13, W_M2, scr, gw, NGW, lane); __syncthreads(); }
                if (idx >= 2048) break;
                att::AttnArgs a; a.cb = nullptr; a.sel = nullptr; a.qg = nullptr; a.ldq = LDZ0; a.ldk = LDZ0; a.ldv = LDZ0; a.ldo = 1024; a.j_lo = 0;
                if (idx < 1536) { const int qb = 15 - idx / 96, r = idx % 96; a.P0 = qb * 256; a.j_hi = 4 * (qb + 1);
                    if (r < 64) { const int b = r >> 4, h = (r >> 2) & 3, m = (r >> 1) & 1, vh = r & 1; const bf16_t* zb = Z + (size_t)(b * T) * LDZ0;
                        a.Q = zb + (size_t)a.P0 * LDZ0 + ZDQ + (h * 2 + m) * HD; a.K = zb + ZDK + (h * 2 + m) * HD; a.V = zb + ZDV + h * 256 + vh * HD;
                        a.O = (m ? O2 : O1) + (size_t)(b * T + a.P0) * 1024 + h * 256 + vh * HD;
                        att::attn_block<att::M_CAUSAL>((char*)lds, a, tq); }
                    else { const int r2 = r - 64, b = r2 >> 3, hq = r2 & 7, g2 = hq >> 2; const bf16_t* zb = Z + (size_t)(b * T) * LDZ0;
                        a.Q = zb + (size_t)a.P0 * LDZ0 + ZQ + hq * HD; a.K = zb + ZKV + (4 + g2) * HD; a.V = zb + ZKV + (6 + g2) * HD;
                        a.O = OS + (size_t)(b * T + a.P0) * 1024 + hq * HD; a.sel = SEL + (size_t)(b * 2 + g2) * T;
                        att::attn_block<att::M_SLC>((char*)lds, a, tq); } }
                else { const int r = idx - 1536, qb = 15 - (r >> 5), r2 = r & 31, b = r2 >> 3, hq = r2 & 7, g2 = hq >> 2; const bf16_t* zb = Z + (size_t)(b * T) * LDZ0;
                    a.P0 = qb * 256; a.j_hi = 4 * (qb + 1); a.j_lo = (a.P0 - 511) > 0 ? ((a.P0 - 511) >> 6) : 0;
                    a.Q = zb + (size_t)a.P0 * LDZ0 + ZQ + hq * HD; a.K = zb + ZKV + (8 + g2) * HD; a.V = zb + ZKV + (10 + g2) * HD;
                    a.O = OW + (size_t)(b * T + a.P0) * 1024 + hq * HD;
                    att::attn_block<att::M_WIN>((char*)lds, a, tq); } }
        }
        SEAM(5);
        for (int rep_ = 0; rep_ < (IN(6) ? NREP(6) : 0); ++rep_) { PHASE_LOCALS;
            const float* lamp = KIN(I_DIFFLAM); const float* subg = KIN(I_DIFFSUB);
            const float s1 = wave_sum(lamp[lane] * lamp[HD + lane] + lamp[64 + lane] * lamp[HD + 64 + lane]);
            const float s2 = wave_sum(lamp[2 * HD + lane] * lamp[3 * HD + lane] + lamp[2 * HD + 64 + lane] * lamp[3 * HD + 64 + lane]);
            const float lam_init = 0.2f, lam = __expf(s1) - __expf(s2) + lam_init;
            for (int m = gw; m < NTOK; m += NGW) { const size_t ro = (size_t)m * 1024; bf16_t* om = OMIX + (size_t)m * DM;
                for (int hq = 0; hq < 8; ++hq) { const float gc = GATES[(size_t)m * 24 + hq * 3], gs = GATES[(size_t)m * 24 + hq * 3 + 1], gwn = GATES[(size_t)m * 24 + hq * 3 + 2];
                    const unsigned c = *(const unsigned*)(OC + ro + hq * HD + 2 * lane), s = *(const unsigned*)(OS + ro + hq * HD + 2 * lane), w = *(const unsigned*)(OW + ro + hq * HD + 2 * lane);
                    const float v0 = gc * bf2f((unsigned short)c) + gs * bf2f((unsigned short)s) + gwn * bf2f((unsigned short)w);
                    const float v1 = gc * bf2f((unsigned short)(c >> 16)) + gs * bf2f((unsigned short)(s >> 16)) + gwn * bf2f((unsigned short)(w >> 16));
                    *(unsigned*)(om + hq * HD + 2 * lane) = pk2(v0, v1); }
                for (int h = 0; h < 4; ++h) { const u32x2 a1 = *(const u32x2*)(O1 + ro + h * 256 + 4 * lane), a2 = *(const u32x2*)(O2 + ro + h * 256 + 4 * lane);
                    float v[4]; v[0] = bf2f((unsigned short)a1.x) - lam * bf2f((unsigned short)a2.x); v[1] = bf2f((unsigned short)(a1.x >> 16)) - lam * bf2f((unsigned short)(a2.x >> 16));
                    v[2] = bf2f((unsigned short)a1.y) - lam * bf2f((unsigned short)a2.y); v[3] = bf2f((unsigned short)(a1.y >> 16)) - lam * bf2f((unsigned short)(a2.y >> 16));
                    const float rstd = rsqrtf(wave_sum((v[0] * v[0] + v[1] * v[1]) + (v[2] * v[2] + v[3] * v[3])) * (1.f / 256.f) + EPS) * (1.f - lam_init);
                    const f32x4 sg = *(const f32x4*)(subg + 4 * lane);
                    u32x2 w; w.x = pk2(v[0] * rstd * sg.x, v[1] * rstd * sg.y); w.y = pk2(v[2] * rstd * sg.z, v[3] * rstd * sg.w);
                    *(u32x2*)(om + 1024 + h * 256 + 4 * lane) = w; } }
        }
        SEAM(6);
        for (int rep_ = 0; rep_ < (IN(7) ? NREP(7) : 0); ++rep_) { PHASE_LOCALS; pg8::Dims g{DM, DM * 2, DM * 2, 0}; pg8::DenseOrder S; S.init(OMIX, W_EVOUT, NTOK, DM, DM * 2, DM * 2, G, bx); pg8::EpiResNorm E{xs, x_in, DM, HB, normg + (size_t)1 * DM, SSA};
            pg8::gemm_phase<pg8::EpiResNorm, pg8::DenseOrder>(ldsl, g, S, E, tid); }
        SEAM(7);
      } else {
        for (int rep_ = 0; rep_ < (IN(19) ? NREP(19) : 0); ++rep_) { PHASE_LOCALS; pg8::Dims g{DM, DM * 2, DM * 2, 0}; pg8::DenseOrder S; S.init(HB, W_ODIN, NTOK, LDZ1, DM * 2, DM * 2, G, bx); pg8::EpiBf16 E{Z, LDZ1};
            pg8::gemm_phase<pg8::EpiBf16, pg8::DenseOrder>(ldsl, g, S, E, tid); }
        SEAM(19);
        for (int rep_ = 0; rep_ < (IN(20) ? NREP(20) : 0); ++rep_) { PHASE_LOCALS;
            const float* fg = KIN(I_FOXG);
            for (int m = gw; m < NTOK; m += NGW) { bf16_t* zr = Z + (size_t)m * LDZ1;
#pragma unroll
                for (int q = 0; q < 4; ++q) { group_norm4<false>(zr + Z1Q + q * 512, fg, 4, nullptr, lane); group_norm4<false>(zr + Z1K + q * 512, fg + HD, 4, nullptr, lane); } }
            for (int sq = bx; sq < 64; sq += G) { const int b = sq >> 4, h = sq & 15; const float fb = KIN(I_FOXB)[h];
                const bf16_t* zc = Z + (size_t)(b * T + 8 * tid) * LDZ1 + Z1F + h; float lf[8];
#pragma unroll
                for (int i = 0; i < 8; ++i) lf[i] = bf2f(zc[(size_t)i * LDZ1]);
#pragma unroll
                for (int i = 0; i < 8; ++i) { const float v = lf[i] + fb; lf[i] = fminf(v, 0.f) - log1pf(__expf(-fabsf(v))); }
#pragma unroll
                for (int i = 1; i < 8; ++i) lf[i] += lf[i - 1];
                float incl = lf[7];
#pragma unroll
                for (int o = 1; o < 64; o <<= 1) { const float tv = __shfl_up(incl, o); if (lane >= o) incl += tv; }
                LAS float* wt = (LAS float*)ldsl;
                __syncthreads();
                if (lane == 63) wt[wave] = incl;
                __syncthreads();
                float base = incl - lf[7];
                for (int w = 0; w < wave; ++w) base += wt[w];
                float* cbp = CBUF + (size_t)sq * T + 8 * tid;
                *(f32x4*)cbp = (f32x4){base + lf[0], base + lf[1], base + lf[2], base + lf[3]}; *(f32x4*)(cbp + 4) = (f32x4){base + lf[4], base + lf[5], base + lf[6], base + lf[7]}; }
        }
        SEAM(20);
        for (int rep_ = 0; rep_ < (IN(21) ? NREP(21) : 0); ++rep_) { PHASE_LOCALS; const int tq = tid;
            bool conv = false;
            for (int i = 0;; ++i) { const int idx = deal(i, G, bx);
                if (!conv && (i == (bx & 3) || idx >= 1024)) { conv = true; moe_convert(KIN(I_MOEW1) + (size_t)NEXP * DM * FF, KIN(I_MOEW3) + (size_t)NEXP * DM * FF, KIN(I_MOEW2) + (size_t)NEXP * FF * DM, W_M13, W_M2, scr, gw, NGW, lane); __syncthreads(); }
                if (idx >= 1024) break;
                const int qb = 15 - (idx >> 6), r = idx & 63, b = r >> 4, h = r & 15; const bf16_t* zb = Z + (size_t)(b * T) * LDZ1;
                att::AttnArgs a; a.ldq = LDZ1; a.ldk = LDZ1; a.ldv = LDZ1; a.ldo = DM; a.P0 = qb * 256; a.j_lo = 0; a.j_hi = 4 * (qb + 1); a.sel = nullptr; a.qg = nullptr;
                a.Q = zb + (size_t)a.P0 * LDZ1 + Z1Q + h * HD; a.K = zb + Z1K + h * HD; a.V = zb + Z1V + h * HD; a.O = OMIX + (size_t)(b * T + a.P0) * DM + h * HD; a.cb = CBUF + (size_t)(b * 16 + h) * T;
                att::attn_block<att::M_FOX>((char*)lds, a, tq); }
        }
        SEAM(21);
        for (int rep_ = 0; rep_ < (IN(22) ? NREP(22) : 0); ++rep_) { PHASE_LOCALS; pg8::Dims g{DM, DM * 2, DM * 2, 0}; pg8::DenseOrder S; S.init(OMIX, W_ODOUT, NTOK, DM, DM * 2, DM * 2, G, bx); pg8::EpiResNorm E{xs, xs, DM, HB, normg + (size_t)5 * DM, SSA};
            pg8::gemm_phase<pg8::EpiResNorm, pg8::DenseOrder>(ldsl, g, S, E, tid); }
        SEAM(22);
      }
      const int cb = l ? 23 : 8;
      for (int rep_ = 0; rep_ < (INC(1) ? NREP(100 + 1) : 0); ++rep_) { PHASE_LOCALS; pg8::Dims g{DM, DM * 2, DM * 2, 0}; pg8::DenseOrder S; S.init(HB, W_CAQ + (size_t)l * 512 * DM, NTOK, 512, DM * 2, DM * 2, G, bx); pg8::EpiBf16 E{CAQ, 512};
          pg8::gemm_phase<pg8::EpiBf16, pg8::DenseOrder>(ldsl, g, S, E, tid); }
      SEAM(cb + 1);
      for (int rep_ = 0; rep_ < (INC(2) ? NREP(100 + 2) : 0); ++rep_) { PHASE_LOCALS; const int tq = tid;
          for (int i = 0;; ++i) { const int idx = i * G + bx; if (idx >= 256) break;
              const int b = idx >> 6, h = (idx >> 4) & 3, qb = idx & 15; const bf16_t* kvb = CAKV + (size_t)l * 1024 * 1024 + (size_t)b * 256 * 1024;
              att::AttnArgs a; a.ldq = 512; a.ldk = 1024; a.ldv = 1024; a.ldo = 512; a.P0 = qb * 256; a.j_lo = 0; a.j_hi = 4; a.cb = nullptr; a.sel = nullptr; a.qg = KIN(I_CAG) + (l * 2) * HD;
              a.Q = CAQ + (size_t)(b * T + a.P0) * 512 + h * HD; a.K = kvb + h * HD; a.V = kvb + 512 + h * HD; a.O = OCA + (size_t)(b * T + a.P0) * 512 + h * HD;
              att::attn_block<att::M_NONE>((char*)lds, a, tq); }
      }
      SEAM(cb + 2);
      for (int rep_ = 0; rep_ < (INC(3) ? NREP(100 + 3) : 0); ++rep_) { PHASE_LOCALS; pg8::Dims g{512, 512 * 2, 512 * 2, 0}; pg8::DenseOrder S; S.init(OCA, W_CAO + (size_t)l * DM * 512, NTOK, DM, 512 * 2, 512 * 2, G, bx); pg8::EpiResNorm E{xs, xs, DM, HB, normg + (size_t)(l * 4 + 3) * DM, SSB};
          pg8::gemm_phase<pg8::EpiResNorm, pg8::DenseOrder>(ldsl, g, S, E, tid); }
      SEAM(cb + 3);
      for (int rep_ = 0; rep_ < (INC(5) ? NREP(100 + 5) : 0); ++rep_) { PHASE_LOCALS; pg8::Dims g{DM, DM * 2, DM * 2, 0}; pg8::DenseOrder S; S.init(HB, W_RT + (size_t)l * 256 * DM, NTOK, 256, DM * 2, DM * 2, G, bx); pg8::EpiF32 E{LOGITS, nullptr, 256};
          pg8::gemm_phase<pg8::EpiF32, pg8::DenseOrder>(ldsl, g, S, E, tid); }
      SEAM(cb + 5);
      for (int rep_ = 0; rep_ < (INC(6) ? 1 : 0); ++rep_) { PHASE_LOCALS;
          const float* bg = KIN(I_MOEBG) + l * 4; const float* be = KIN(I_MOEBE) + l * 32; unsigned* cnt = ctl + CW_CNT + 2048 * l;
          LAS int* flist = (LAS int*)ldsl; LAS int* fcnt = (LAS int*)(ldsl + 1024); LAS int* dec_e = (LAS int*)(ldsl + 2048); LAS float* dec_w = (LAS float*)(ldsl + 3072);
          LAS int* lcnt = (LAS int*)(ldsl + 4096); LAS int* lbase = (LAS int*)(ldsl + 4096 + 128);
          for (int m0 = bx * 64; m0 < NTOK; m0 += G * 64) {
              if (tid == 0) *fcnt = 0;
              if (tid < 32) lcnt[tid] = 0;
              __syncthreads();
              if (tid < 64) { const int m = m0 + tid; const RouteDec d = route_decide(LOGITS + (size_t)m * 256, bg, be, row_rstd(SSB + (size_t)m * 32));
                  dec_e[2 * tid] = d.grp * 8 + d.j0; dec_e[2 * tid + 1] = d.grp * 8 + d.j1; dec_w[2 * tid] = d.w0; dec_w[2 * tid + 1] = d.w1;
                  (void)flist; (void)fcnt; }
              __syncthreads();
              int e_ = 0, lr_ = 0;
              if (tid < 128) { e_ = dec_e[tid]; lr_ = __hip_atomic_fetch_add(lcnt + e_, 1, __ATOMIC_RELAXED, __HIP_MEMORY_SCOPE_WORKGROUP); }
              __syncthreads();
              if (tid < 32) { const int c_ = lcnt[tid]; lbase[tid] = c_ ? (int)atomicAdd(cnt + 64 * tid, (unsigned)c_) : 0; }
              __syncthreads();
              if (tid < 128) { const size_t s_ = (size_t)2 * m0 + tid; R_EID[s_] = e_; R_WT[s_] = dec_w[tid]; R_RANK[s_] = lbase[e_] + lr_; }
              __syncthreads();
          }
      }
      SEAM(cb + 6);
      if (INC(7) || INC(8) || INC(9)) { PHASE_LOCALS;
          if (tid == 0) { const unsigned* cnt = ctl + CW_CNT + 2048 * l; int acc = 0; for (int e = 0; e < NEXP; ++e) { tstart[e] = acc; acc += (int)((__hip_atomic_load(cnt + 64 * e, __ATOMIC_RELAXED, __HIP_MEMORY_SCOPE_AGENT) + 255u) >> 8); } tstart[NEXP] = acc; }
          __syncthreads();
      }
      for (int rep_ = 0; rep_ < (INC(7) ? NREP(100 + 7) : 0); ++rep_) { PHASE_LOCALS;
          for (int s = gw; s < 2 * NTOK; s += NGW) { const int e = R_EID[s], dest = tstart[e] * 256 + R_RANK[s]; if (lane == 0) { R_SLOT[s] = dest; R_RS[dest] = row_rstd(SSB + (size_t)(s >> 1) * 32); }
              const u32x4* src = (const u32x4*)(HB + (size_t)(s >> 1) * DM) + lane; u32x4* dst = (u32x4*)(XS + (size_t)dest * DM) + lane;
#pragma unroll
              for (int j = 0; j < 4; ++j) dst[64 * j] = src[64 * j]; }
      }
      SEAM(cb + 7);
      for (int rep_ = 0; rep_ < (INC(8) ? NREP(100 + 8) : 0); ++rep_) { PHASE_LOCALS; pg8::Dims g{DM, DM * 2, DM * 2, 0}; MoeOrder S{(const char*)XS, (size_t)256 * DM * 2, (const char*)W_M13, (size_t)1024 * DM * 2, (size_t)256 * DM * 2, 4, tstart[NEXP] * 4, G, bx, tstart};
          pg8::EpiSwiglu E{HM, R_RS}; pg8::gemm_phase<pg8::EpiSwiglu, MoeOrder>(ldsl, g, S, E, tid); }
      SEAM(cb + 8);
      for (int rep_ = 0; rep_ < (INC(9) ? NREP(100 + 9) : 0); ++rep_) { PHASE_LOCALS; pg8::Dims g{FF, FF * 2, FF * 2, 0}; MoeOrder S{(const char*)HM, (size_t)256 * FF * 2, (const char*)W_M2, (size_t)DM * FF * 2, (size_t)256 * FF * 2, 8, tstart[NEXP] * 8, G, bx, tstart};
          pg8::EpiBf16 E{YB, DM}; pg8::gemm_phase<pg8::EpiBf16, MoeOrder>(ldsl, g, S, E, tid); }
      SEAM(cb + 9);
      for (int rep_ = 0; rep_ < (INC(10) ? NREP(100 + 10) : 0); ++rep_) { PHASE_LOCALS;
          for (int m = gw; m < NTOK; m += NGW) { const float w0 = R_WT[2 * m], w1 = R_WT[2 * m + 1]; const u32x2* y0 = (const u32x2*)(YB + (size_t)R_SLOT[2 * m] * DM) + lane; const u32x2* y1 = (const u32x2*)(YB + (size_t)R_SLOT[2 * m + 1] * DM) + lane;
              f32x4* xr = (f32x4*)(xs + (size_t)m * DM) + lane; f32x4 v[8]; float ss = 0.f;
#pragma unroll
              for (int j = 0; j < 8; ++j) { const u32x2 a = y0[64 * j], b = y1[64 * j]; f32x4 x = xr[64 * j];
                  x.x += w0 * bf2f((unsigned short)a.x) + w1 * bf2f((unsigned short)b.x); x.y += w0 * bf2f((unsigned short)(a.x >> 16)) + w1 * bf2f((unsigned short)(b.x >> 16));
                  x.z += w0 * bf2f((unsigned short)a.y) + w1 * bf2f((unsigned short)b.y); x.w += w0 * bf2f((unsigned short)(a.y >> 16)) + w1 * bf2f((unsigned short)(b.y >> 16));
                  xr[64 * j] = x; v[j] = x; ss += (x.x * x.x + x.y * x.y) + (x.z * x.z + x.w * x.w); }
              if (l == 0) { const float rstd = rsqrtf(wave_sum(ss) * (1.f / DM) + EPS); const f32x4* gr = (const f32x4*)(normg + (size_t)4 * DM) + lane; u32x2* o8 = (u32x2*)(HB + (size_t)m * DM) + lane;
#pragma unroll
                  for (int j = 0; j < 8; ++j) { const f32x4 gg = gr[64 * j]; u32x2 w; w.x = pk2(v[j].x * rstd * gg.x, v[j].y * rstd * gg.y); w.y = pk2(v[j].z * rstd * gg.z, v[j].w * rstd * gg.w); o8[64 * j] = w; } } }
      }
      if (l == 0) SEAM(cb + 10);
    }
#undef IN
#undef INC
#undef SEAM
}

extern "C" void kernel_launch(void* const* d_in, const int* in_sizes, int n_in, void* d_out, int out_size, void* d_ws, size_t ws_size, hipStream_t stream) {
    static int grid = 0;
    if (grid == 0) {
        if (n_in != 27 || out_size != NTOK * DM || ws_size < WS_END) { fprintf(stderr, "kernel_launch: unexpected shapes (n_in %d out %d ws %zu)\n", n_in, out_size, ws_size); grid = -1; return; }
        int dev = 0, cus = 0, per_cu = 0;
        if (hipGetDevice(&dev) != hipSuccess || hipDeviceGetAttribute(&cus, hipDeviceAttributeMultiprocessorCount, dev) != hipSuccess) { grid = -1; return; }
        if (hipFuncSetAttribute((const void*)mk_fwd, hipFuncAttributeMaxDynamicSharedMemorySize, LDS_BYTES) != hipSuccess) { grid = -1; return; }
        if (hipOccupancyMaxActiveBlocksPerMultiprocessor(&per_cu, (const void*)mk_fwd, 512, LDS_BYTES) != hipSuccess || per_cu < 1) fprintf(stderr, "kernel_launch: occupancy query says %d\n", per_cu);
        (void)hipGetLastError();
        grid = cus;
    }
    if (grid < 0) return;
    (void)hipMemsetAsync((char*)d_ws + WS_CTL, 0, CTL_ZERO_BYTES, stream);
    Args a{};
    for (int i = 0; i < 27; ++i) a.in[i] = (const float*)d_in[i];
    a.out = (float*)d_out; a.ws = (unsigned char*)d_ws;
#ifndef MK_CUTS
    a.ph_lo = 0; a.ph_hi = NPHASE;
    hipLaunchKernelGGL(mk_fwd, dim3(grid), dim3(512), LDS_BYTES, stream, a);
#else
    for (int p = 0; p < NPHASE; ++p) { a.ph_lo = p; a.ph_hi = p + 1; hipLaunchKernelGGL(mk_fwd, dim3(grid), dim3(512), LDS_BYTES, stream, a); }
#endif
}
```
